# Optimizing an MI355X kernel written in HIP

```python
import math
import jax
import jax.numpy as jnp
from jax import lax
import numpy as np

D_MODEL = 2048
BATCH = 4
SEQ = 4096
DEPTH = 4

BLOCK = 128
N_BRANCH = 4
BRANCH_W = D_MODEL // 4
A_HEADS = 4
A_HD = BRANCH_W // (2 * A_HEADS)
B_WIDTH = BRANCH_W
B_BLOCKS = 8
B_CONV = 4
B_C = 8.0
C_HEADS = 4
C_HD = BRANCH_W // C_HEADS
D_HEADS = 8
D_KV = 2
D_GROUP = D_HEADS // D_KV
D_HD = BRANCH_W // D_HEADS
WINDOW = 128
D_FF = -(-8 * D_MODEL // (3 * 256)) * 256

IN_SIZES = (
    2 * A_HEADS * A_HD, 2 * A_HEADS * A_HD, 2 * A_HEADS * A_HD,
    B_WIDTH, B_WIDTH,
    C_HEADS * C_HD, C_HEADS * C_HD, C_HEADS * C_HD, C_HEADS,
    D_HEADS * D_HD, D_KV * D_HD, D_KV * D_HD,
    N_BRANCH * D_MODEL,
)
IN_COLS = sum(IN_SIZES)
RMS_EPS = 1e-6
NEG_INF = -1e30

kernel_name = 'hybrid_gated_diff_rglru_fox_swa_block'


def rms_norm(x, g):
    xf = x.astype(jnp.float32)
    y = xf * lax.rsqrt(jnp.mean(xf * xf, axis=-1, keepdims=True) + RMS_EPS)
    return (y * g.astype(jnp.float32)).astype(x.dtype)


def alibi_slopes(n):
    return jnp.exp2(-8.0 * jnp.arange(1, n + 1, dtype=jnp.float32) / n)


def diff_attention(q, k, v, lam, slopes):
    B, S, H, _, dh = q.shape
    nb = S // BLOCK
    scale = dh ** -0.5
    qb = q.reshape(B, nb, BLOCK, H, 2, dh).transpose(1, 0, 2, 3, 4, 5)
    kpos = jnp.arange(S)

    def one_block(args):
        qblk, i = args
        qpos = i * BLOCK + jnp.arange(BLOCK)
        dist = (qpos[:, None] - kpos[None, :]).astype(jnp.float32)
        logits = jnp.einsum('bqhmd,bshmd->bmhqs', qblk, k).astype(jnp.float32) * scale
        logits = logits - slopes[:, None, None] * dist
        logits = jnp.where(dist >= 0, logits, NEG_INF)
        p = jax.nn.softmax(logits, axis=-1)
        w = p[:, 0] - lam * p[:, 1]
        return jnp.einsum('bhqs,bshe->bqhe', w.astype(v.dtype), v)

    out = lax.map(one_block, (qb, jnp.arange(nb)))
    return out.transpose(1, 0, 2, 3, 4).reshape(B, S, H, 2 * dh)


def rg_lru_branch(xb, gb, conv_w, conv_b, wa, ba, wx, bx, lam):
    B, S, C = xb.shape
    xc = lax.conv_general_dilated(xb, conv_w[:, None, :], window_strides=(1,),
                                  padding=[(B_CONV - 1, 0)],
                                  dimension_numbers=('NWC', 'WIO', 'NWC'),
                                  feature_group_count=C) + conv_b
    xg = xc.reshape(B, S, B_BLOCKS, C // B_BLOCKS)
    r = jax.nn.sigmoid(jnp.einsum('bsnc,ncd->bsnd', xg, wa).reshape(B, S, C) + ba)
    i = jax.nn.sigmoid(jnp.einsum('bsnc,ncd->bsnd', xg, wx).reshape(B, S, C) + bx)
    log_a = -B_C * r.astype(jnp.float32) * jax.nn.softplus(-lam.astype(jnp.float32))
    a = jnp.exp(log_a)
    u = jnp.sqrt(-jnp.expm1(2.0 * log_a)) * (i * xc).astype(jnp.float32)

    def combine(left, right):
        a1, b1 = left
        a2, b2 = right
        return a1 * a2, a2 * b1 + b2

    _, h = lax.associative_scan(combine, (a, u), axis=1)
    return jax.nn.gelu(gb) * h.astype(xb.dtype)


def forgetting_attention(q, k, v, logf):
    B, S, H, dh = q.shape
    nb = S // BLOCK
    scale = dh ** -0.5
    cum = jnp.cumsum(logf, axis=1).transpose(0, 2, 1)
    qb = q.reshape(B, nb, BLOCK, H, dh).transpose(1, 0, 2, 3, 4)
    cqb = cum.reshape(B, H, nb, BLOCK).transpose(2, 0, 1, 3)
    kpos = jnp.arange(S)

    def one_block(args):
        qblk, cq, i = args
        qpos = i * BLOCK + jnp.arange(BLOCK)
        causal = qpos[:, None] >= kpos[None, :]
        logits = jnp.einsum('bqhd,bshd->bhqs', qblk, k).astype(jnp.float32) * scale
        logits = logits + cq[..., None] - cum[:, :, None, :]
        logits = jnp.where(causal, logits, NEG_INF)
        p = jax.nn.softmax(logits, axis=-1)
        return jnp.einsum('bhqs,bshd->bqhd', p.astype(v.dtype), v)

    out = lax.map(one_block, (qb, cqb, jnp.arange(nb)))
    return out.transpose(1, 0, 2, 3, 4).reshape(B, S, H * dh)


def sliding_window_sink_attention(q, k, v, sinks, slopes):
    B, S, KV, G, dh = q.shape
    nb = S // BLOCK
    scale = dh ** -0.5
    pad = ((0, 0), (BLOCK, 0), (0, 0), (0, 0))

    def band(t):
        tp = jnp.pad(t, pad)
        prev = tp[:, :S].reshape(B, nb, BLOCK, KV, dh)
        cur = tp[:, BLOCK:].reshape(B, nb, BLOCK, KV, dh)
        return jnp.concatenate([prev, cur], axis=2)

    kb, vb = band(k), band(v)
    qb = q.reshape(B, nb, BLOCK, KV, G, dh)
    qi = jnp.arange(BLOCK)
    kj = jnp.arange(2 * BLOCK) - BLOCK
    dist = (qi[:, None] - kj[None, :]).astype(jnp.float32)
    key_pos = jnp.arange(nb)[:, None] * BLOCK + kj[None, :]
    valid = ((dist >= 0) & (dist < WINDOW))[None] & (key_pos >= 0)[:, None, :]
    logits = jnp.einsum('bnqkgd,bnskd->bnkgqs', qb, kb).astype(jnp.float32) * scale
    logits = logits - slopes.reshape(KV, G)[:, :, None, None] * dist
    logits = jnp.where(valid[None, :, None, None], logits, NEG_INF)
    sink = sinks.astype(jnp.float32).reshape(KV, G)[None, None, :, :, None, None]
    m = jnp.maximum(jnp.max(logits, axis=-1, keepdims=True), sink)
    e = jnp.exp(logits - m)
    p = e / (jnp.sum(e, axis=-1, keepdims=True) + jnp.exp(sink - m))
    out = jnp.einsum('bnkgqs,bnskd->bnqkgd', p.astype(v.dtype), vb)
    return out.reshape(B, S, KV * G * dh)


def setup_inputs(seed: int = 0) -> dict:
    key = jax.random.key(seed)
    ks = jax.random.split(key, 26)
    f32 = jnp.float32

    def nrm(k, shape, scale):
        return jax.random.normal(k, shape, f32) * scale

    bw = B_WIDTH // B_BLOCKS
    a8 = jax.random.uniform(ks[15], (DEPTH, B_WIDTH), f32, 0.9, 0.999)
    a0 = a8 ** (1.0 / B_C)
    return {
        'x': nrm(ks[0], (BATCH, SEQ, D_MODEL), 1.0),
        'norm_mix': 1.0 + nrm(ks[1], (DEPTH, D_MODEL), 0.02),
        'w_in': nrm(ks[2], (DEPTH, D_MODEL, IN_COLS), D_MODEL ** -0.5),
        'b_gate': nrm(ks[3], (DEPTH, N_BRANCH * D_MODEL), 0.02),
        'diff_lq1': nrm(ks[4], (DEPTH, A_HD), 0.1),
        'diff_lk1': nrm(ks[5], (DEPTH, A_HD), 0.1),
        'diff_lq2': nrm(ks[6], (DEPTH, A_HD), 0.1),
        'diff_lk2': nrm(ks[7], (DEPTH, A_HD), 0.1),
        'diff_subln': 1.0 + nrm(ks[8], (DEPTH, 2 * A_HD), 0.02),
        'lru_conv_w': nrm(ks[9], (DEPTH, B_CONV, B_WIDTH), B_CONV ** -0.5),
        'lru_conv_b': nrm(ks[10], (DEPTH, B_WIDTH), 0.02),
        'lru_wa': nrm(ks[11], (DEPTH, B_BLOCKS, bw, bw), bw ** -0.5),
        'lru_ba': nrm(ks[12], (DEPTH, B_WIDTH), 0.02),
        'lru_wx': nrm(ks[13], (DEPTH, B_BLOCKS, bw, bw), bw ** -0.5),
        'lru_bx': nrm(ks[14], (DEPTH, B_WIDTH), 0.02),
        'lru_lambda': jnp.log(a0) - jnp.log1p(-a0),
        'fox_b_f': 2.0 + nrm(ks[16], (DEPTH, C_HEADS), 0.5),
        'swa_sinks': nrm(ks[17], (DEPTH, D_HEADS), 0.5),
        'w_branch': nrm(ks[18], (DEPTH, N_BRANCH, BRANCH_W, D_MODEL), BRANCH_W ** -0.5),
        'w_out': nrm(ks[19], (DEPTH, D_MODEL, D_MODEL), D_MODEL ** -0.5),
        'norm_ffn': 1.0 + nrm(ks[20], (DEPTH, D_MODEL), 0.02),
        'w_ffn_gate': nrm(ks[21], (DEPTH, D_MODEL, D_FF), D_MODEL ** -0.5),
        'w_ffn_up': nrm(ks[22], (DEPTH, D_MODEL, D_FF), D_MODEL ** -0.5),
        'w_ffn_down': nrm(ks[23], (DEPTH, D_FF, D_MODEL), D_FF ** -0.5),
        'norm_final': 1.0 + nrm(ks[24], (D_MODEL,), 0.02),
    }


def reference(x, norm_mix, w_in, b_gate, diff_lq1, diff_lk1, diff_lq2, diff_lk2, diff_subln,
              lru_conv_w, lru_conv_b, lru_wa, lru_ba, lru_wx, lru_bx, lru_lambda,
              fox_b_f, swa_sinks, w_branch, w_out, norm_ffn, w_ffn_gate, w_ffn_up, w_ffn_down,
              norm_final):
    B, S, _ = x.shape
    slopes_a = alibi_slopes(A_HEADS)
    slopes_d = alibi_slopes(D_HEADS)
    split_points = []
    acc = 0
    for size in IN_SIZES[:-1]:
        acc += size
        split_points.append(acc)

    h = x
    for l in range(DEPTH):
        u = rms_norm(h, norm_mix[l])
        z = u @ w_in[l]
        (aq, ak, av, bxin, bgate, cq, ck, cv, cf, dq, dk, dv, gz) = jnp.split(z, split_points, axis=-1)

        lam_init = 0.8 - 0.6 * math.exp(-0.3 * l)
        lam = (jnp.exp(jnp.sum(diff_lq1[l].astype(jnp.float32) * diff_lk1[l].astype(jnp.float32)))
               - jnp.exp(jnp.sum(diff_lq2[l].astype(jnp.float32) * diff_lk2[l].astype(jnp.float32)))
               + lam_init)
        ya = diff_attention(aq.reshape(B, S, A_HEADS, 2, A_HD), ak.reshape(B, S, A_HEADS, 2, A_HD),
                            av.reshape(B, S, A_HEADS, 2 * A_HD), lam, slopes_a)
        ya = (rms_norm(ya, diff_subln[l]) * (1.0 - lam_init)).reshape(B, S, BRANCH_W)

        yb = rg_lru_branch(bxin, bgate, lru_conv_w[l], lru_conv_b[l], lru_wa[l], lru_ba[l],
                           lru_wx[l], lru_bx[l], lru_lambda[l])

        logf = jax.nn.log_sigmoid((cf + fox_b_f[l]).astype(jnp.float32))
        yc = forgetting_attention(cq.reshape(B, S, C_HEADS, C_HD), ck.reshape(B, S, C_HEADS, C_HD),
                                  cv.reshape(B, S, C_HEADS, C_HD), logf)

        yd = sliding_window_sink_attention(dq.reshape(B, S, D_KV, D_GROUP, D_HD),
                                           dk.reshape(B, S, D_KV, D_HD), dv.reshape(B, S, D_KV, D_HD),
                                           swa_sinks[l], slopes_d)

        gates = jax.nn.sigmoid(gz + b_gate[l]).reshape(B, S, N_BRANCH, D_MODEL)
        branches = (ya, yb, yc, yd)
        mixed = gates[:, :, 0] * (branches[0] @ w_branch[l, 0])
        for n in range(1, N_BRANCH):
            mixed = mixed + gates[:, :, n] * (branches[n] @ w_branch[l, n])
        h = h + mixed @ w_out[l]

        v = rms_norm(h, norm_ffn[l])
        h = h + (jax.nn.silu(v @ w_ffn_gate[l]) * (v @ w_ffn_up[l])) @ w_ffn_down[l]

    return rms_norm(h, norm_final)
```

```cpp
#include <hip/hip_runtime.h>
#include <cstdio>
#include <cstdint>
namespace pg8 {
#define PG8_LAS __attribute__((address_space(3)))
typedef unsigned short bf16_t;
typedef short bf16x8 __attribute__((ext_vector_type(8)));
typedef float f32x4 __attribute__((ext_vector_type(4)));
typedef unsigned u32x4 __attribute__((ext_vector_type(4)));
constexpr int BM = 256, BK = 64, HALF = 128, HTB = HALF * BK * 2  , STAGE_BYTES = 8 * HTB, NXCD = 8, WGM = 8;

__host__ __device__ __forceinline__ int lds_byte(int r, int c) { const int st = (r >> 4) * 2 + (c >> 5), rr = r & 15, cc = c & 31, ob = rr * 64 + cc * 2; return st * 1024 + (ob ^ (((ob >> 9) & 1) << 5)); }
__host__ __device__ __forceinline__ void stage_rc(int b, int& R, int& C) { const int st = b / 1024, sb = b % 1024, swz = sb ^ (((sb >> 9) & 1) << 5); R = (st >> 1) * 16 + swz / 64; C = (st & 1) * 32 + (swz % 64) / 2; }
__host__ __device__ __forceinline__ int perm32(int rho) { const int n = rho >> 4, i = rho & 15; return 8 * (i >> 2) + 4 * n + (i & 3); }

struct Unit { int pm, pn; };
struct Gemm { const bf16_t* A; const bf16_t* Bt; int M, N, K; };

struct StaticOrder {
    int nM, nN, nwg, G, c;
    __host__ __device__ void init(int M, int N, int G_, int c_) { nM = M / BM; nN = N / BM; nwg = nM * nN; G = G_; c = c_; }
    __host__ __device__ bool next(int i, Unit& u) const {
        const long L = (long)i * G + c; if (L >= nwg) return false;
        int wgid = (int)L; { const int q = nwg / NXCD, r = nwg % NXCD, xcd = wgid % NXCD, off = wgid / NXCD; wgid = (xcd < r ? xcd * (q + 1) : r * (q + 1) + (xcd - r) * q) + off; }
        const int nig = WGM * nN, gid = wgid / nig, fm = gid * WGM, gsz = (nM - fm) < WGM ? (nM - fm) : WGM;
        u.pm = fm + ((wgid % nig) % gsz); u.pn = (wgid % nig) / gsz; return true;
    }
    __device__ __forceinline__ void a_ready(const Unit&) const {}
    __device__ __forceinline__ void done(const Unit&) const {}
};

typedef float f32x2c __attribute__((ext_vector_type(2))); typedef __bf16 bf16x2c __attribute__((ext_vector_type(2)));
__device__ __forceinline__ unsigned cvt_pk_bf16(float lo, float hi) { f32x2c v = {lo, hi}; bf16x2c b = __builtin_convertvector(v, bf16x2c); return __builtin_bit_cast(unsigned, b); }
typedef float f32x2 __attribute__((ext_vector_type(2)));

typedef unsigned u32x2v __attribute__((ext_vector_type(2)));
__device__ __forceinline__ float sigmoid_f(float x, float nl2e) { return __builtin_amdgcn_rcpf(1.0f + __builtin_amdgcn_exp2f(nl2e * x)); }
#define PG8_NL2E(v) float v = -1.4426950408889634f; asm volatile("" : "+v"(v))

struct EpiZ {
    static constexpr bool PERM = true, AFTER_DRAIN = false; static constexpr int KSEG = 0;
    bf16_t* Z; bf16_t* G; const float* bgate;
    __device__ __forceinline__ void operator()(const f32x4 (&acc)[2][2][4][2], const Unit& u, int wr, int wc, int fr, int fq) const {
        const int row0 = u.pm * BM + wr * 64 + fr;
        if (u.pn < 19) {
            const int col0 = u.pn * BM + wc * 32 + 8 * fq;
#pragma unroll
            for (int ai = 0; ai < 2; ++ai)
#pragma unroll
                for (int m = 0; m < 4; ++m) { bf16_t* rowp = Z + (size_t)(row0 + ai * HALF + m * 16) * 4864 + col0;
#pragma unroll
                    for (int bj = 0; bj < 2; ++bj) { const f32x4 v0 = acc[ai][bj][m][0], v1 = acc[ai][bj][m][1];
                        u32x4 w; w.x = cvt_pk_bf16(v0[0], v0[1]); w.y = cvt_pk_bf16(v0[2], v0[3]); w.z = cvt_pk_bf16(v1[0], v1[1]); w.w = cvt_pk_bf16(v1[2], v1[3]);
                        *(u32x4*)(rowp + bj * HALF) = w; } }
        } else {
            const int col0 = (u.pn - 19) * BM + wc * 32 + 8 * fq;
            PG8_NL2E(nl2e);
            f32x4 bv[2][2];
#pragma unroll
            for (int bj = 0; bj < 2; ++bj)
#pragma unroll
                for (int n = 0; n < 2; ++n) bv[bj][n] = *(const f32x4*)(bgate + col0 + bj * HALF + 4 * n);
#pragma unroll
            for (int ai = 0; ai < 2; ++ai)
#pragma unroll
                for (int m = 0; m < 4; ++m) { bf16_t* rowp = G + (size_t)(row0 + ai * HALF + m * 16) * 8192 + col0;
#pragma unroll
                    for (int bj = 0; bj < 2; ++bj) { f32x4 v0 = acc[ai][bj][m][0] + bv[bj][0], v1 = acc[ai][bj][m][1] + bv[bj][1];
#pragma unroll
                        for (int e = 0; e < 4; ++e) { v0[e] = sigmoid_f(v0[e], nl2e); v1[e] = sigmoid_f(v1[e], nl2e); }
                        u32x4 w; w.x = cvt_pk_bf16(v0[0], v0[1]); w.y = cvt_pk_bf16(v0[2], v0[3]); w.z = cvt_pk_bf16(v1[0], v1[1]); w.w = cvt_pk_bf16(v1[2], v1[3]);
                        *(u32x4*)(rowp + bj * HALF) = w; } }
        }
    }
};

struct EpiResid {
    static constexpr bool PERM = true, AFTER_DRAIN = false; static constexpr int KSEG = 0;
    const float* src; float* dst;
    __device__ __forceinline__ void operator()(const f32x4 (&acc)[2][2][4][2], const Unit& u, int wr, int wc, int fr, int fq) const {
        const int row0 = u.pm * BM + wr * 64 + fr, col0 = u.pn * BM + wc * 32 + 8 * fq;
#pragma unroll
        for (int ai = 0; ai < 2; ++ai)
#pragma unroll
            for (int m = 0; m < 4; ++m) { const size_t off = (size_t)(row0 + ai * HALF + m * 16) * 2048 + col0;
#pragma unroll
                for (int bj = 0; bj < 2; ++bj)
#pragma unroll
                    for (int n = 0; n < 2; ++n) { const f32x4 r = *(const f32x4*)(src + off + bj * HALF + 4 * n); *(f32x4*)(dst + off + bj * HALF + 4 * n) = r + acc[ai][bj][m][n]; } }
    }
};

struct EpiSwiGLU {
    static constexpr bool PERM = true, AFTER_DRAIN = false; static constexpr int KSEG = 0;
    bf16_t* HID;
    __device__ __forceinline__ void operator()(const f32x4 (&acc)[2][2][4][2], const Unit& u, int wr, int wc, int fr, int fq) const {
        const int row0 = u.pm * BM + wr * 64 + fr, col0 = u.pn * HALF + wc * 32 + 8 * fq;
        PG8_NL2E(nl2e);
#pragma unroll
        for (int ai = 0; ai < 2; ++ai)
#pragma unroll
            for (int m = 0; m < 4; ++m) { bf16_t* rowp = HID + (size_t)(row0 + ai * HALF + m * 16) * 5632 + col0;
                f32x4 v0, v1;
#pragma unroll
                for (int e = 0; e < 4; ++e) { const float g0 = acc[ai][0][m][0][e], g1 = acc[ai][0][m][1][e];
                    v0[e] = g0 * sigmoid_f(g0, nl2e) * acc[ai][1][m][0][e]; v1[e] = g1 * sigmoid_f(g1, nl2e) * acc[ai][1][m][1][e]; }
                u32x4 w; w.x = cvt_pk_bf16(v0[0], v0[1]); w.y = cvt_pk_bf16(v0[2], v0[3]); w.z = cvt_pk_bf16(v1[0], v1[1]); w.w = cvt_pk_bf16(v1[2], v1[3]);
                *(u32x4*)rowp = w; }
    }
};

__device__ __forceinline__ void bf8_to_f32(const u32x4 w, float (&f)[8]) {
    f[0] = __builtin_bit_cast(float, w.x << 16); f[1] = __builtin_bit_cast(float, w.x & 0xffff0000u);
    f[2] = __builtin_bit_cast(float, w.y << 16); f[3] = __builtin_bit_cast(float, w.y & 0xffff0000u);
    f[4] = __builtin_bit_cast(float, w.z << 16); f[5] = __builtin_bit_cast(float, w.z & 0xffff0000u);
    f[6] = __builtin_bit_cast(float, w.w << 16); f[7] = __builtin_bit_cast(float, w.w & 0xffff0000u);
}
struct EpiMix {
    static constexpr bool PERM = true, AFTER_DRAIN = false; static constexpr int KSEG = 8;
    const bf16_t* G; bf16_t* MIX;
    __device__ __forceinline__ void kseg(f32x4 (&acc)[2][2][4][2], const Unit& u, int i, int wr, int wc, int fr, int fq) const {
        const int row0 = u.pm * BM + wr * 64 + fr, col0 = u.pn * BM + wc * 32 + 8 * fq;
#pragma unroll
        for (int ai = 0; ai < 2; ++ai)
#pragma unroll
            for (int m = 0; m < 4; ++m) { const bf16_t* rowp = G + (size_t)(row0 + ai * HALF + m * 16) * 8192 + col0;
#pragma unroll
                for (int bj = 0; bj < 2; ++bj) {
                    const u32x4 wp = *(const u32x4*)(rowp + (i - 1) * 2048 + bj * HALF), wn = *(const u32x4*)(rowp + i * 2048 + bj * HALF);
                    float gp[8], gn[8]; bf8_to_f32(wp, gp); bf8_to_f32(wn, gn);
#pragma unroll
                    for (int e = 0; e < 4; ++e) { acc[ai][bj][m][0][e] *= fmaxf(gp[e], 1e-30f) * __builtin_amdgcn_rcpf(fmaxf(gn[e], 1e-30f));
                                                  acc[ai][bj][m][1][e] *= fmaxf(gp[4 + e], 1e-30f) * __builtin_amdgcn_rcpf(fmaxf(gn[4 + e], 1e-30f)); } } }
    }
    __device__ __forceinline__ void operator()(const f32x4 (&acc)[2][2][4][2], const Unit& u, int wr, int wc, int fr, int fq) const {
        const int row0 = u.pm * BM + wr * 64 + fr, col0 = u.pn * BM + wc * 32 + 8 * fq;
#pragma unroll
        for (int ai = 0; ai < 2; ++ai)
#pragma unroll
            for (int m = 0; m < 4; ++m) { const size_t ro = (size_t)(row0 + ai * HALF + m * 16);
#pragma unroll
                for (int bj = 0; bj < 2; ++bj) {
                    const u32x4 wg = *(const u32x4*)(G + ro * 8192 + 3 * 2048 + col0 + bj * HALF);
                    float g[8]; bf8_to_f32(wg, g);
#pragma unroll
                    for (int e = 0; e < 8; ++e) g[e] = fmaxf(g[e], 1e-30f);
                    const f32x4 a0 = acc[ai][bj][m][0], a1 = acc[ai][bj][m][1];
                    u32x4 w; w.x = cvt_pk_bf16(a0[0] * g[0], a0[1] * g[1]); w.y = cvt_pk_bf16(a0[2] * g[2], a0[3] * g[3]);
                             w.z = cvt_pk_bf16(a1[0] * g[4], a1[1] * g[5]); w.w = cvt_pk_bf16(a1[2] * g[6], a1[3] * g[7]);
                    *(u32x4*)(MIX + ro * 2048 + col0 + bj * HALF) = w; } }
    }
};


template <class Epi, class Sched, bool ALIGN_EPI = false, bool SP2 = false>
__device__ __forceinline__ void gemm_phase(PG8_LAS unsigned char* lds, const Gemm g, const Sched& S, const Epi& E) {
    int tid_ = threadIdx.x; asm volatile("" : "+v"(tid_));
    const int tid = tid_, wid = __builtin_amdgcn_readfirstlane(tid >> 6), lane = tid & 63, wr = wid >> 2, wc = wid & 3, fr = lane & 15, fq = lane >> 4;
    const int K = g.K, nt = K / BK;
    unsigned voffA[2], voffB[2];
#pragma unroll
    for (int i = 0; i < 2; ++i) { int R, C; stage_rc(tid * 16 + i * 8192, R, C); const int Rb = Epi::PERM ? ((R & ~31) + perm32(R & 31)) : R;
        voffA[i] = (unsigned)(R * K + C) * 2u; voffB[i] = (unsigned)(Rb * K + C) * 2u; }
    const size_t kstep = (size_t)(BK * 2);
    const size_t hstep = (size_t)HALF * K * 2;
    const size_t tstep = 2 * hstep;
    const unsigned ldsw = (unsigned)wid * 1024u;
    const int aoff = lds_byte(wr * 64 + fr, fq * 8), boff = lds_byte(wc * 32 + fr, fq * 8);
#define PG8_SA(b, h) (((b) * 2 + (h)) * HTB)
#define PG8_SB(b, h) ((4 + (b) * 2 + (h)) * HTB)
#define PG8_STAGE(bufoff, gbase, voff) do { _Pragma("unroll") for (int _i = 0; _i < 2; ++_i) \
        __builtin_amdgcn_global_load_lds((const unsigned*)((const char*)(gbase) + (voff)[_i]), (PG8_LAS unsigned*)(lds + (bufoff) + ldsw + _i * 8192), 16, 0, 0); } while (0)
#define PG8_LDA(dst, b, h) do { _Pragma("unroll") for (int m = 0; m < 4; ++m) _Pragma("unroll") for (int k = 0; k < 2; ++k) dst[m][k] = *(const PG8_LAS bf16x8*)(lds + PG8_SA(b, h) + aoff + m * 2048 + k * 1024); } while (0)
#define PG8_LDB(dst, b, h) do { _Pragma("unroll") for (int n = 0; n < 2; ++n) _Pragma("unroll") for (int k = 0; k < 2; ++k) dst[n][k] = *(const PG8_LAS bf16x8*)(lds + PG8_SB(b, h) + boff + n * 2048 + k * 1024); } while (0)
#define PG8_MMA(ai, bj, At, Bt) do { __builtin_amdgcn_s_setprio(1); _Pragma("unroll") for (int m = 0; m < 4; ++m) _Pragma("unroll") for (int n = 0; n < 2; ++n) _Pragma("unroll") for (int k = 0; k < 2; ++k) \
        acc[ai][bj][m][n] = __builtin_amdgcn_mfma_f32_16x16x32_bf16(Bt[n][k], At[m][k], acc[ai][bj][m][n], 0, 0, 0); __builtin_amdgcn_s_setprio(0); } while (0)
#define PG8_WAIT_V(n) asm volatile("s_waitcnt vmcnt(" #n ")" ::: "memory")
#define PG8_WAIT_L(n) asm volatile("s_waitcnt lgkmcnt(" #n ")" ::: "memory")
#define PG8_BAR __builtin_amdgcn_s_barrier()
#define PG8_SCHED __builtin_amdgcn_sched_barrier(0)
    Unit cur, nxt; int ui = 0;
    if (!S.next(0, cur)) return;
    f32x4 acc[2][2][4][2];
#pragma unroll
    for (int a = 0; a < 2; ++a)
#pragma unroll
        for (int b = 0; b < 2; ++b)
#pragma unroll
            for (int m = 0; m < 4; ++m)
#pragma unroll
                for (int n = 0; n < 2; ++n) acc[a][b][m][n] = (f32x4){0.f, 0.f, 0.f, 0.f};
    bf16x8 At[4][2], B0[2][2], B1[2][2];
    const char* cA = (const char*)g.A + (size_t)cur.pm * tstep; const char* cB = (const char*)g.Bt + (size_t)cur.pn * tstep;
    S.a_ready(cur);
    if constexpr (SP2) {
        PG8_STAGE(PG8_SB(0, 0), cB, voffB); PG8_STAGE(PG8_SB(0, 1), cB + hstep, voffB); PG8_STAGE(PG8_SA(0, 0), cA, voffA); PG8_STAGE(PG8_SA(0, 1), cA + hstep, voffA);
        if (wr == 1) PG8_BAR;
        PG8_WAIT_V(2); PG8_BAR;
        PG8_STAGE(PG8_SB(1, 0), cB + kstep, voffB); PG8_STAGE(PG8_SA(1, 0), cA + kstep, voffA); PG8_STAGE(PG8_SB(1, 1), cB + hstep + kstep, voffB);
        PG8_WAIT_V(6); PG8_BAR;
    } else {
        PG8_STAGE(PG8_SB(0, 0), cB, voffB); PG8_STAGE(PG8_SA(0, 0), cA, voffA); PG8_STAGE(PG8_SB(0, 1), cB + hstep, voffB); PG8_STAGE(PG8_SA(0, 1), cA + hstep, voffA);
        if (wr == 1) PG8_BAR;
        PG8_WAIT_V(4); PG8_BAR;
        PG8_STAGE(PG8_SB(1, 0), cB + kstep, voffB); PG8_STAGE(PG8_SA(1, 0), cA + kstep, voffA); PG8_STAGE(PG8_SB(1, 1), cB + hstep + kstep, voffB);
        PG8_WAIT_V(6); PG8_BAR;
    }
    for (;;) {
        const bool has_next = S.next(ui + 1, nxt);
        const char* nA = has_next ? (const char*)g.A + (size_t)nxt.pm * tstep : cA; const char* nB = has_next ? (const char*)g.Bt + (size_t)nxt.pn * tstep : cB;
        for (int t = 0; t < nt; t += 2) {
            if constexpr (Epi::KSEG > 0) { if (t != 0 && (t % Epi::KSEG) == 0) E.kseg(acc, cur, t / Epi::KSEG, wr, wc, fr, fq); }
            const bool last = (t == nt - 2);
            const char* a1 = cA + (size_t)(t + 1) * kstep;
            const char* a2 = last ? nA : cA + (size_t)(t + 2) * kstep; const char* b2 = last ? nB : cB + (size_t)(t + 2) * kstep;
            const char* a3 = a2 + kstep; const char* b3 = b2 + kstep;
            if (last && has_next) S.a_ready(nxt);
            if constexpr (SP2) {
            PG8_LDB(B0, 0, 0); PG8_LDB(B1, 0, 1); PG8_SCHED; PG8_LDA(At, 0, 0); PG8_STAGE(PG8_SA(1, 1), a1 + hstep, voffA);
            PG8_WAIT_V(8); PG8_WAIT_L(0); PG8_BAR; PG8_MMA(0, 0, At, B0); PG8_MMA(0, 1, At, B1); PG8_BAR; PG8_SCHED;
            PG8_LDA(At, 0, 1); PG8_STAGE(PG8_SB(0, 0), b2, voffB); PG8_STAGE(PG8_SB(0, 1), b2 + hstep, voffB); PG8_STAGE(PG8_SA(0, 0), a2, voffA);
            PG8_WAIT_V(8); PG8_WAIT_L(0); PG8_BAR; PG8_MMA(1, 0, At, B0); PG8_MMA(1, 1, At, B1); PG8_BAR; PG8_SCHED;
            PG8_LDB(B0, 1, 0); PG8_LDB(B1, 1, 1); PG8_SCHED; PG8_LDA(At, 1, 0); PG8_STAGE(PG8_SA(0, 1), a2 + hstep, voffA);
            PG8_WAIT_V(8); PG8_WAIT_L(0); PG8_BAR; PG8_MMA(0, 0, At, B0); PG8_MMA(0, 1, At, B1); PG8_BAR; PG8_SCHED;
            PG8_LDA(At, 1, 1); PG8_STAGE(PG8_SB(1, 0), b3, voffB); PG8_STAGE(PG8_SB(1, 1), b3 + hstep, voffB); PG8_STAGE(PG8_SA(1, 0), a3, voffA);
            PG8_WAIT_V(8); PG8_WAIT_L(0); PG8_BAR; PG8_MMA(1, 0, At, B0); PG8_MMA(1, 1, At, B1); PG8_BAR; PG8_SCHED;
            } else {
            PG8_LDB(B0, 0, 0); PG8_SCHED; PG8_LDA(At, 0, 0); PG8_STAGE(PG8_SA(1, 1), a1 + hstep, voffA);
            PG8_WAIT_L(8); PG8_BAR; PG8_WAIT_L(0); PG8_MMA(0, 0, At, B0); PG8_BAR; PG8_SCHED;
            PG8_LDB(B1, 0, 1); PG8_STAGE(PG8_SB(0, 0), b2, voffB);
            PG8_BAR; PG8_WAIT_L(0); PG8_MMA(0, 1, At, B1); PG8_BAR;
            PG8_LDA(At, 0, 1); PG8_STAGE(PG8_SA(0, 0), a2, voffA);
            PG8_BAR; PG8_WAIT_L(0); PG8_MMA(1, 0, At, B0); PG8_BAR; PG8_SCHED;
            PG8_STAGE(PG8_SB(0, 1), b2 + hstep, voffB);
            PG8_WAIT_V(6); PG8_BAR; PG8_MMA(1, 1, At, B1); PG8_BAR;
            PG8_LDB(B0, 1, 0); PG8_SCHED; PG8_LDA(At, 1, 0); PG8_STAGE(PG8_SA(0, 1), a2 + hstep, voffA);
            PG8_WAIT_L(8); PG8_BAR; PG8_WAIT_L(0); PG8_MMA(0, 0, At, B0); PG8_BAR; PG8_SCHED;
            PG8_LDB(B1, 1, 1); PG8_STAGE(PG8_SB(1, 0), b3, voffB);
            PG8_BAR; PG8_WAIT_L(0); PG8_MMA(0, 1, At, B1); PG8_BAR;
            PG8_LDA(At, 1, 1); PG8_STAGE(PG8_SA(1, 0), a3, voffA);
            PG8_BAR; PG8_WAIT_L(0); PG8_MMA(1, 0, At, B0); PG8_BAR; PG8_SCHED;
            PG8_STAGE(PG8_SB(1, 1), b3 + hstep, voffB);
            PG8_WAIT_V(6); PG8_BAR; PG8_MMA(1, 1, At, B1); PG8_BAR;
            }
        }
        if constexpr (ALIGN_EPI) { if (wr == 0) PG8_BAR; }
        if constexpr (!Epi::AFTER_DRAIN) { E(acc, cur, wr, wc, fr, fq); S.done(cur); }
        if (!has_next) break;
#pragma unroll
        for (int a = 0; a < 2; ++a)
#pragma unroll
            for (int b = 0; b < 2; ++b)
#pragma unroll
                for (int m = 0; m < 4; ++m)
#pragma unroll
                    for (int n = 0; n < 2; ++n) acc[a][b][m][n] = (f32x4){0.f, 0.f, 0.f, 0.f};
        cur = nxt; cA = nA; cB = nB; ++ui;
        if constexpr (ALIGN_EPI) { if (wr == 1) PG8_BAR; }
    }
    PG8_WAIT_V(0);
    if constexpr (!ALIGN_EPI) { if (wr == 0) PG8_BAR; }
    PG8_BAR;
    if constexpr (Epi::AFTER_DRAIN) { E.fused(acc, cur, wr, wc, fr, fq, lds, wid, lane); S.done(cur); }
#undef PG8_SA
#undef PG8_SB
#undef PG8_STAGE
#undef PG8_LDA
#undef PG8_LDB
#undef PG8_MMA
#undef PG8_WAIT_V
#undef PG8_WAIT_L
#undef PG8_BAR
#undef PG8_SCHED
}
}

constexpr int NWAVES = 8, NTHREADS = 512;
constexpr int BATCH = 4, SEQ = 4096, DM = 2048, DEPTH = 4, M = BATCH * SEQ;
constexpr int IN_COLS = 13060, NIN = 13056, ZP = 4864, GP = 8192, DFF = 5632, NGU = 2 * DFF;
constexpr float RMS_EPS = 1e-6f, LOG2E = 1.4426950408889634f, NEGBIG = -1e30f;
constexpr int ZC_AQ = 0, ZC_AK = 512, ZC_AV = 1024, ZC_BX = 1536, ZC_BG = 2048, ZC_CQ = 2560, ZC_CK = 3072, ZC_CV = 3584, ZC_DQ = 4096, ZC_DK = 4608, ZC_DV = 4736;

constexpr size_t MiB = 1u << 20;
constexpr size_t WS_CTL = 0, CTL_ZERO_BYTES = 1 * MiB;
constexpr size_t WS_WCF = 1 * MiB;
constexpr size_t WS_LRUK = 1 * MiB + 512 * 1024;
constexpr size_t WS_LOGF = 2 * MiB;
constexpr size_t WS_W = 4 * MiB, W_LAYER = 133 * MiB;
constexpr size_t WO_IN = 0, WO_BR = 51 * MiB, WO_OUT = 59 * MiB, WO_GU = 67 * MiB, WO_DN = 111 * MiB;
constexpr size_t WS_H = WS_W + DEPTH * W_LAYER;
constexpr size_t WS_U = WS_H + 128 * MiB;
constexpr size_t WS_Z = WS_U + 64 * MiB;
constexpr size_t WS_G = WS_Z + 152 * MiB;
constexpr size_t WS_Y = WS_G + 256 * MiB;
constexpr size_t WS_MIX = WS_Y + 64 * MiB;
constexpr size_t WS_OSCR = WS_MIX + 64 * MiB;
constexpr size_t WS_END = WS_OSCR + 32 * MiB;
static_assert((size_t)M * ZP * 2 <= 152 * MiB && (size_t)M * DFF * 2 <= 256 * MiB && (size_t)NIN * DM * 2 == 51 * MiB && (size_t)NGU * DM * 2 == 44 * MiB, "d_ws map");
constexpr int CW_BAR = 4096;
constexpr int CW_Q = 16384;

constexpr int RING_OFF = 0, RING_BYTES = 131072;
constexpr int LDSCTL_OFF = RING_BYTES, MISC_OFF = LDSCTL_OFF + 320;
constexpr int LDS_BYTES = 147456;
constexpr int MX_KIMG = 0, MX_VIMG = 32768, MX_BIAS = 65536, MX_SCR = 81920;
constexpr int LR_P = 68;
constexpr int LR_XC = 0, LR_A = 34816, LR_U = 69632, LR_WT = 104448, LR_SEGA = 122880, LR_SEGH = 124928, LR_CARRY = 126976;
static_assert(LR_CARRY + 512 <= RING_BYTES && LR_WT + 128 * 144 <= LR_SEGA, "LRU LDS map");

#define XB_LAS __attribute__((address_space(3)))

#define GAS __attribute__((address_space(1)))
#define LAS __attribute__((address_space(3)))
typedef unsigned short bf16;
typedef unsigned v4u __attribute__((ext_vector_type(4)));
typedef float f32x4 __attribute__((ext_vector_type(4)));
typedef short bf16x8 __attribute__((ext_vector_type(8)));
typedef GAS unsigned gu32;
typedef GAS unsigned long long gu64;
#define RLX_AGENT __ATOMIC_RELAXED, __HIP_MEMORY_SCOPE_AGENT
#define LDS_WAIT() asm volatile("s_waitcnt lgkmcnt(0)" ::: "memory")
#define VM_WAIT() asm volatile("s_waitcnt vmcnt(0)" ::: "memory")
__device__ __forceinline__ unsigned long long rt() { return __builtin_amdgcn_s_memrealtime(); }
__device__ __forceinline__ unsigned f2bf(float f) { unsigned u = __builtin_bit_cast(unsigned, f); return (u + 0x7fffu + ((u >> 16) & 1u)) >> 16; }
__device__ __forceinline__ unsigned pk2(float lo, float hi) { return f2bf(lo) | (f2bf(hi) << 16); }

#define XB_TMO      128
#define XB_XCNT(j)  (256  + 64 * (j))
#define XB_XSUB(j)  (1280 + 64 * (j))
#define XB_XGEN(j)  (2304 + 64 * (j))
#define XB_TOP      3328
#define XB_TOPGEN   3392
#define XCD_BAR_WORDS 3456
#define XB_SPIN_CAP (1u << 18)

__device__ __forceinline__ unsigned xb_ld(unsigned* p)              { return __hip_atomic_load(p, __ATOMIC_RELAXED, __HIP_MEMORY_SCOPE_AGENT); }
__device__ __forceinline__ unsigned xb_add(unsigned* p, unsigned v) { return __hip_atomic_fetch_add(p, v, __ATOMIC_RELAXED, __HIP_MEMORY_SCOPE_AGENT); }
__device__ __forceinline__ unsigned xb_xcc_id() { return (unsigned)__builtin_amdgcn_s_getreg((3 << 11) | 20) & 0xFu; }
#define XB_SPIN(cond, bar) do { unsigned _sp = 0; while (cond) { __builtin_amdgcn_s_sleep(1); \
    if ((++_sp & 255u) == 0u) { if (xb_ld(&(bar)[XB_TMO])) break; if (_sp > XB_SPIN_CAP) { atomicAdd(&(bar)[XB_TMO], 1u); break; } } } } while (0)

struct XcdBarrier {
    unsigned* bar; unsigned x;
    volatile LAS unsigned* st;
};

__device__ __forceinline__ XcdBarrier xcd_barrier_post(unsigned* bar, volatile LAS unsigned* st) {
    XcdBarrier b; b.bar = bar; b.x = xb_xcc_id(); b.st = st;
    if (threadIdx.x == 0) (void)xb_add(&bar[XB_XCNT(b.x)], 1u);
    return b;
}
__device__ __forceinline__ void xcd_barrier_complete(unsigned* bar, unsigned x, unsigned& nloc, unsigned& nx) {
    const unsigned G = gridDim.x * gridDim.y * gridDim.z;
    unsigned sum, cnt, mine, sp = 0u;
    for (;;) {
        sum = 0u; cnt = 0u; mine = 0u;
#pragma unroll
        for (unsigned j = 0; j < 16; ++j) { const unsigned c = xb_ld(&bar[XB_XCNT(j)]); sum += c; cnt += (c > 0u) ? 1u : 0u; mine = (j == x) ? c : mine; }
        if (sum == G) break;
        __builtin_amdgcn_s_sleep(1);
        if ((++sp & 255u) == 0u) { if (xb_ld(&bar[XB_TMO])) break; if (sp > XB_SPIN_CAP) { atomicAdd(&bar[XB_TMO], 1u); break; } }
    }
    nloc = mine > 0u ? mine : 1u; nx = cnt > 0u ? cnt : 1u;
}

__device__ __forceinline__ void xcd_barrier(const XcdBarrier& b) {
    asm volatile("s_waitcnt vmcnt(0)" ::: "memory");
    __syncthreads();
    if (threadIdx.x == 0) {
        unsigned* bar = b.bar;
        __builtin_amdgcn_s_waitcnt(0);
        unsigned nloc = b.st[0], nx = b.st[1];
        if (nloc == 0u) { xcd_barrier_complete(bar, b.x, nloc, nx); b.st[0] = nloc; b.st[1] = nx; }
        const unsigned old = xb_add(&bar[XB_XSUB(b.x)], 1u);
        const unsigned gen = old / nloc;
        if (old + 1u == (gen + 1u) * nloc) {
            __builtin_amdgcn_fence(__ATOMIC_RELEASE, "agent");
            asm volatile("s_waitcnt vmcnt(0)" ::: "memory");
            const unsigned og = xb_add(&bar[XB_TOP], 1u);
            const unsigned tg = og / nx;
            if (og + 1u == (tg + 1u) * nx) xb_add(&bar[XB_TOPGEN], 1u);
            else XB_SPIN(xb_ld(&bar[XB_TOPGEN]) == tg, bar);
            __builtin_amdgcn_fence(__ATOMIC_ACQUIRE, "agent");
            xb_add(&bar[XB_XGEN(b.x)], 1u);
            asm volatile("s_waitcnt vmcnt(0)" ::: "memory");
        } else {
            XB_SPIN(xb_ld(&bar[XB_XGEN(b.x)]) == gen, bar);
            __builtin_amdgcn_fence(__ATOMIC_ACQUIRE, "agent");
            asm volatile("s_waitcnt vmcnt(0)" ::: "memory");
        }
    }
    __syncthreads();
}


typedef float f32x16 __attribute__((ext_vector_type(16)));
typedef short v4i16_t __attribute__((ext_vector_type(4)));
typedef float f32x2_t __attribute__((ext_vector_type(2)));
typedef __bf16 bf16x2_t __attribute__((ext_vector_type(2)));
typedef unsigned u32x2 __attribute__((ext_vector_type(2)));
__device__ __forceinline__ unsigned cvtpk(float lo, float hi) { f32x2_t v = {lo, hi}; bf16x2_t b = __builtin_convertvector(v, bf16x2_t); return __builtin_bit_cast(unsigned, b); }
__device__ __forceinline__ float opq(float x) { asm volatile("" : "+v"(x)); return x; }
__device__ __forceinline__ float bf2f(bf16 h) { return __builtin_bit_cast(float, (unsigned)h << 16); }
__device__ __forceinline__ float wave_sum(float v) {
#pragma unroll
    for (int o = 1; o < 64; o <<= 1) v += __shfl_xor(v, o);
    return v;
}

struct Args { const float* in[25]; float* out; unsigned char* ws; int ph_lo, ph_hi; };
struct Frame {
    LAS unsigned char* lds;
    gu32* ctl;
    int tid, lane, wave, vcu, G;
    const Args* a;
    float* out;
    unsigned char* ws;
};
enum { I_X = 0, I_NORM_MIX, I_W_IN, I_B_GATE, I_LQ1, I_LK1, I_LQ2, I_LK2, I_SUBLN, I_CONV_W, I_CONV_B, I_WA, I_BA, I_WX, I_BX, I_LAMBDA, I_FOX_B, I_SINKS, I_W_BRANCH, I_W_OUT, I_NORM_FFN, I_W_GATE, I_W_UP, I_W_DOWN, I_NORM_FINAL };

__device__ __forceinline__ void tr_item(const float* src, int ldsrc, int scol0, bf16* dst, int lddst, int drow0, int dcol0, LAS float* scr, int lane) {
#pragma unroll 8
    for (int i = 0; i < 32; ++i) { const int kk = 2 * i + (lane >> 5); scr[kk * 33 + (lane & 31)] = src[(size_t)kk * ldsrc + scol0 + (lane & 31)]; }
    LDS_WAIT(); asm volatile("" ::: "memory");
    const int c = lane & 7;
#pragma unroll
    for (int j = 0; j < 4; ++j) { const int n = (lane >> 3) + 8 * j; const LAS float* s = scr + (8 * c) * 33 + n;
        v4u o; o.x = cvtpk(s[0 * 33], s[1 * 33]); o.y = cvtpk(s[2 * 33], s[3 * 33]); o.z = cvtpk(s[4 * 33], s[5 * 33]); o.w = cvtpk(s[6 * 33], s[7 * 33]);
        *(GAS v4u*)(dst + (size_t)(drow0 + n) * lddst + dcol0 + 8 * c) = o; }
    LDS_WAIT(); asm volatile("" ::: "memory");
}
__device__ __forceinline__ void p0_weights(Frame& F) {
    LAS float* scr = (LAS float*)(F.lds + RING_OFF + F.wave * 16384);
    const int gw = F.vcu * NWAVES + F.wave, NGW = F.G * NWAVES;
    constexpr int I_IN = 32 * 408, I_BR = 2048, I_OUT = 2048, I_G = 32 * 176, I_D = 88 * 64, PER_LAYER = I_IN + I_BR + I_OUT + 2 * I_G + I_D;
    for (int it = gw; it < DEPTH * PER_LAYER; it += NGW) {
        const int l = it / PER_LAYER; int r = it % PER_LAYER;
        unsigned char* wl = F.ws + WS_W + (size_t)l * W_LAYER;
        if (r < I_IN) { const int kb = r / 408, nb = r % 408, n0 = 32 * nb;
            tr_item(F.a->in[I_W_IN] + ((size_t)l * DM + 64 * kb) * IN_COLS, IN_COLS, n0 < 4096 ? n0 : n0 + 4, (bf16*)(wl + WO_IN), DM, n0, 64 * kb, scr, F.lane); continue; }
        r -= I_IN;
        if (r < I_BR) { const int nbr = r / 512, q = r % 512, kb = q / 64, nb = q % 64;
            tr_item(F.a->in[I_W_BRANCH] + (((size_t)l * 4 + nbr) * 512 + 64 * kb) * DM, DM, 32 * nb, (bf16*)(wl + WO_BR), DM, 32 * nb, 512 * nbr + 64 * kb, scr, F.lane); continue; }
        r -= I_BR;
        if (r < I_OUT) { const int kb = r / 64, nb = r % 64;
            tr_item(F.a->in[I_W_OUT] + ((size_t)l * DM + 64 * kb) * DM, DM, 32 * nb, (bf16*)(wl + WO_OUT), DM, 32 * nb, 64 * kb, scr, F.lane); continue; }
        r -= I_OUT;
        if (r < 2 * I_G) { const int up = r / I_G, q = r % I_G, kb = q / 176, nb = q % 176, n0 = 32 * nb;
            tr_item(F.a->in[up ? I_W_UP : I_W_GATE] + ((size_t)l * DM + 64 * kb) * DFF, DFF, n0, (bf16*)(wl + WO_GU), DM, (n0 >> 7) * 256 + (n0 & 127) + 128 * up, 64 * kb, scr, F.lane); continue; }
        r -= 2 * I_G;
        { const int kb = r / 64, nb = r % 64;
            tr_item(F.a->in[I_W_DOWN] + ((size_t)l * DFF + 64 * kb) * DM, DM, 32 * nb, (bf16*)(wl + WO_DN), DFF, 32 * nb, 64 * kb, scr, F.lane); }
    }
    for (int i = (F.vcu * NTHREADS + F.tid); i < DEPTH * 512; i += F.G * NTHREADS) { const float lm = F.a->in[I_LAMBDA][i]; ((float*)(F.ws + WS_LRUK))[i] = -8.0f * (fmaxf(-lm, 0.f) + log1pf(__expf(-fabsf(lm)))); }
    float* wcf = (float*)(F.ws + WS_WCF);
    for (int i = (F.vcu * NTHREADS + F.tid); i < DEPTH * DM; i += F.G * NTHREADS) { const int l = i / DM, k = i % DM;
        const float* w = F.a->in[I_W_IN] + ((size_t)l * DM + k) * IN_COLS + 4096;
        f32x4 o; o.x = w[0]; o.y = w[1]; o.z = w[2]; o.w = w[3]; *(f32x4*)(wcf + 4 * (size_t)i) = o; }
}

template <int MODE> __device__ __forceinline__ void norm_phase(Frame& F, const float* src, const float* gain, bf16* U, float* outf, int layer) {
    const int gw = F.vcu * NWAVES + F.wave, NGW = F.G * NWAVES;
    f32x4 g[8];
#pragma unroll
    for (int j = 0; j < 8; ++j) g[j] = *(const f32x4*)(gain + 4 * F.lane + 256 * j);
    for (int m = gw; m < M; m += NGW) {
        const float* xr = src + (size_t)m * DM + 4 * F.lane;
        f32x4 v[8]; float ss = 0.f;
#pragma unroll
        for (int j = 0; j < 8; ++j) { v[j] = *(const f32x4*)(xr + 256 * j); ss += (v[j].x * v[j].x + v[j].y * v[j].y) + (v[j].z * v[j].z + v[j].w * v[j].w); }
        const float rstd = rsqrtf(wave_sum(ss) * (1.f / DM) + RMS_EPS);
#pragma unroll
        for (int j = 0; j < 8; ++j) v[j] = v[j] * rstd * g[j];
        if (MODE == 2) {
            float* orow = outf + (size_t)m * DM + 4 * F.lane;
#pragma unroll
            for (int j = 0; j < 8; ++j) *(f32x4*)(orow + 256 * j) = v[j];
        } else {
            bf16* orow = U + (size_t)m * DM + 4 * F.lane;
#pragma unroll
            for (int j = 0; j < 8; ++j) { u32x2 w; w.x = cvtpk(v[j].x, v[j].y); w.y = cvtpk(v[j].z, v[j].w); *(u32x2*)(orow + 256 * j) = w; }
        }
        if (MODE == 1) {
            const float* wc = (const float*)(F.ws + WS_WCF) + (size_t)layer * DM * 4;
            float c0 = 0.f, c1 = 0.f, c2 = 0.f, c3 = 0.f;
#pragma unroll
            for (int j = 0; j < 8; ++j)
#pragma unroll
                for (int e = 0; e < 4; ++e) { const f32x4 w = *(const f32x4*)(wc + 4 * (size_t)(4 * F.lane + 256 * j + e)); const float u = v[j][e];
                    c0 += u * w.x; c1 += u * w.y; c2 += u * w.z; c3 += u * w.w; }
            c0 = wave_sum(c0); c1 = wave_sum(c1); c2 = wave_sum(c2); c3 = wave_sum(c3);
            if (F.lane == 0) { const float* fb = F.a->in[I_FOX_B] + 4 * layer; f32x4 o; float cc[4] = {c0 + fb[0], c1 + fb[1], c2 + fb[2], c3 + fb[3]};
#pragma unroll
                for (int e = 0; e < 4; ++e) { const float x = cc[e]; o[e] = fminf(x, 0.f) - __logf(1.0f + __expf(-fabsf(x))); }
                *(f32x4*)((float*)(F.ws + WS_LOGF) + 4 * (size_t)m) = o; }
        }
    }
}


__device__ __forceinline__ unsigned off_b(unsigned row, unsigned ch) { return 256u * row + 16u * (ch ^ (((row & 3u) << 2) | ((row >> 2) & 3u))); }
__device__ __forceinline__ v4i16_t tr_read(const LAS unsigned char* p) { return __builtin_amdgcn_ds_read_tr16_b64_v4i16((LAS v4i16_t*)p); }

template <int NS, int NC, bool WINDOW>
__device__ __forceinline__ void attn_pass(LAS unsigned char* L, const bf16* __restrict__ Kg, const bf16* __restrict__ Vg, const bf16* __restrict__ Qlane, const int s0, const int c0,
                                          const int t_lo, const int t_hi, const int qpos, const int wq_min, const int wq_max, const int bias_k0, const float C2,
                                          f32x16 (&o)[NC], float& m_run, float& l_run) {
    int tid_ = threadIdx.x; asm volatile("" : "+v"(tid_));
    const int tid = tid_, lane = tid & 63, hi = lane >> 5, l31 = lane & 31;
    bf16x8 qf[NS];
#pragma unroll
    for (int s = 0; s < NS; ++s) qf[s] = *(const bf16x8*)(Qlane + 16 * s + 8 * hi);
#pragma unroll
    for (int c = 0; c < NC; ++c)
#pragma unroll
        for (int r = 0; r < 16; ++r) o[c][r] = 0.f;
    m_run = NEGBIG; l_run = 0.f;
    const int wv = __builtin_amdgcn_readfirstlane(tid >> 6);
    const int srow = 4 * wv + (lane >> 4);
    const int sch = (lane & 15) ^ (((srow & 3) << 2) | ((srow >> 2) & 3));
    const bf16* kgp = Kg + (size_t)srow * ZP + sch * 8;
    const bf16* vgp = Vg + (size_t)srow * ZP + sch * 8;
#define MX_DMA(t_, buf_) do { const size_t g_ = (size_t)(t_) * 64 * ZP; const int lb_ = (buf_) * 16384 + wv * 1024; \
        __builtin_amdgcn_global_load_lds((const unsigned*)(kgp + g_), (LAS unsigned*)(L + MX_KIMG + lb_), 16, 0, 0); \
        __builtin_amdgcn_global_load_lds((const unsigned*)(kgp + g_ + (size_t)32 * ZP), (LAS unsigned*)(L + MX_KIMG + lb_ + 8192), 16, 0, 0); \
        __builtin_amdgcn_global_load_lds((const unsigned*)(vgp + g_), (LAS unsigned*)(L + MX_VIMG + lb_), 16, 0, 0); \
        __builtin_amdgcn_global_load_lds((const unsigned*)(vgp + g_ + (size_t)32 * ZP), (LAS unsigned*)(L + MX_VIMG + lb_ + 8192), 16, 0, 0); } while (0)
    const unsigned xr = ((unsigned)(l31 & 3) << 2) | ((unsigned)(l31 >> 2) & 3u);
    const unsigned krow = 256u * (unsigned)l31;
    const unsigned blk = (lane >> 4) & 1, q4 = (lane & 15) >> 2, p = lane & 3;
    const unsigned trb0 = 256u * (4u * hi + q4) + 8u * (p & 1), trb1 = trb0 + 2048u;
    const unsigned xt0 = (q4 << 2) | ((unsigned)hi & 3u), xt1 = (q4 << 2) | (((unsigned)hi + 2u) & 3u);
    const unsigned cl = 2u * blk + (p >> 1);
    MX_DMA(t_lo, 0);
    asm volatile("s_waitcnt vmcnt(0)" ::: "memory");
    __syncthreads();
    for (int t = t_lo; t < t_hi; ++t) {
        const int buf = (t - t_lo) & 1;
        if (t + 1 < t_hi) MX_DMA(t + 1, buf ^ 1);
        const int k0 = 64 * t;
        const bool skip = (k0 > wq_max) || (WINDOW && (k0 + 63 < wq_min - 127));
        if (!skip) {
            const LAS unsigned char* Kb = L + MX_KIMG + buf * 16384;
            const LAS unsigned char* Vb = L + MX_VIMG + buf * 16384;
            f32x16 sa[2];
#pragma unroll
            for (int b = 0; b < 2; ++b) {
                f32x16 acc;
#pragma unroll
                for (int r = 0; r < 16; ++r) acc[r] = 0.f;
#pragma unroll
                for (int s = 0; s < NS; ++s) { const unsigned ch = (unsigned)(2 * (s0 + s) + hi);
                    const bf16x8 kf = *(const LAS bf16x8*)(Kb + b * 8192 + krow + 16u * (ch ^ xr));
                    acc = __builtin_amdgcn_mfma_f32_32x32x16_bf16(kf, qf[s], acc, 0, 0, 0); }
                sa[b] = acc;
            }
            const LAS float* bl = (const LAS float*)(L + MX_BIAS) + (k0 - bias_k0) + 4 * hi;
#pragma unroll
            for (int b = 0; b < 2; ++b)
#pragma unroll
                for (int rr = 0; rr < 4; ++rr) { const f32x4 bv = *(const LAS f32x4*)(bl + 32 * b + 8 * rr);
#pragma unroll
                    for (int e = 0; e < 4; ++e) sa[b][4 * rr + e] = __builtin_fmaf(sa[b][4 * rr + e], C2, bv[e]); }
            const bool need_mask = (k0 + 63 > wq_min) || (WINDOW && (k0 < wq_max - 127));
            if (need_mask) {
#pragma unroll
                for (int b = 0; b < 2; ++b)
#pragma unroll
                    for (int r = 0; r < 16; ++r) { const int kpos = k0 + 32 * b + (r & 3) + 8 * (r >> 2) + 4 * hi;
                        const bool bad = (kpos > qpos) || (WINDOW && (qpos - kpos >= 128));
                        sa[b][r] = bad ? NEGBIG : sa[b][r]; }
            }
            float mt = sa[0][0];
#pragma unroll
            for (int r = 1; r < 16; ++r) mt = fmaxf(mt, sa[0][r]);
#pragma unroll
            for (int r = 0; r < 16; ++r) mt = fmaxf(mt, sa[1][r]);
            mt = fmaxf(mt, __shfl_xor(mt, 32));
            const float mnew = fmaxf(m_run, mt);
            const float alpha = __builtin_amdgcn_exp2f(m_run - mnew);
            m_run = mnew;
            float ls = 0.f;
#pragma unroll
            for (int b = 0; b < 2; ++b)
#pragma unroll
                for (int r = 0; r < 16; ++r) { const float pv = __builtin_amdgcn_exp2f(sa[b][r] - mnew); sa[b][r] = pv; ls += pv; }
            l_run = l_run * alpha + ls;
#pragma unroll
            for (int c = 0; c < NC; ++c)
#pragma unroll
                for (int r = 0; r < 16; ++r) o[c][r] *= alpha;
            bf16x8 pf[4];
#pragma unroll
            for (int ks = 0; ks < 4; ++ks) { const int b = ks >> 1, r0 = 8 * (ks & 1);
                v4u w; w.x = cvtpk(sa[b][r0 + 0], sa[b][r0 + 1]); w.y = cvtpk(sa[b][r0 + 2], sa[b][r0 + 3]); w.z = cvtpk(sa[b][r0 + 4], sa[b][r0 + 5]); w.w = cvtpk(sa[b][r0 + 6], sa[b][r0 + 7]);
                pf[ks] = __builtin_bit_cast(bf16x8, w); }
#pragma unroll
            for (int c = 0; c < NC; ++c) {
                const unsigned chb = 4u * (unsigned)(c0 + c) + cl;
                const unsigned a0 = trb0 + 16u * (chb ^ xt0), a1 = trb1 + 16u * (chb ^ xt1);
#pragma unroll
                for (int ks = 0; ks < 4; ++ks) {
                    const v4i16_t lo = tr_read(Vb + ks * 4096 + a0), hv = tr_read(Vb + ks * 4096 + a1);
                    const bf16x8 vf = (bf16x8){lo[0], lo[1], lo[2], lo[3], hv[0], hv[1], hv[2], hv[3]};
                    o[c] = __builtin_amdgcn_mfma_f32_32x32x16_bf16(vf, pf[ks], o[c], 0, 0, 0);
                }
            }
        }
        asm volatile("s_waitcnt vmcnt(0)" ::: "memory");
        __syncthreads();
    }
#undef MX_DMA
}

template <int NC> __device__ __forceinline__ void store_o(bf16* Y, size_t grow, int colbase, int hi, const f32x16 (&o)[NC]) {
    bf16* yp = Y + grow * DM + colbase + 4 * hi;
#pragma unroll
    for (int c = 0; c < NC; ++c)
#pragma unroll
        for (int rr = 0; rr < 4; ++rr) { u32x2 w; w.x = cvtpk(o[c][4 * rr + 0], o[c][4 * rr + 1]); w.y = cvtpk(o[c][4 * rr + 2], o[c][4 * rr + 3]); *(u32x2*)(yp + 32 * c + 8 * rr) = w; }
}

__device__ __forceinline__ void unit_A(Frame& F, int layer, int b, int h, int qb) {
    LAS unsigned char* L = F.lds + RING_OFF;
    const bf16* Z = (const bf16*)(F.ws + WS_Z); bf16* Y = (bf16*)(F.ws + WS_Y);
    const int hi = F.lane >> 5, l31 = F.lane & 31, q0 = 256 * qb, wq_min = q0 + 32 * F.wave, qpos = wq_min + l31;
    const size_t rb = (size_t)b * SEQ;
    const float L2E = opq(LOG2E);
    const float slope2 = exp2f(-2.0f * (float)(h + 1)) * L2E;
    LAS float* bias = (LAS float*)(L + MX_BIAS);
    const int nkeys = q0 + 256;
    for (int i = F.tid; i < nkeys; i += NTHREADS) bias[i] = slope2 * (float)(i - q0);
    const bf16* Kg = Z + rb * ZP + ZC_AK + 128 * h; const bf16* Vg = Z + rb * ZP + ZC_AV + 128 * h;
    const bf16* Ql = Z + (rb + qpos) * ZP + ZC_AQ + 128 * h;
    const float C2 = 0.125f * L2E;
    f32x16 o1[4], o2[4]; float m1, l1, m2, l2;
    attn_pass<4, 4, false>(L, Kg, Vg, Ql, 0, 0, 0, nkeys / 64, qpos, wq_min, wq_min + 31, 0, C2, o1, m1, l1);
    l1 += __shfl_xor(l1, 32);
    f32x4* park = (f32x4*)(F.ws + WS_OSCR) + ((size_t)(blockIdx.x * NWAVES + F.wave) * 16) * 64 + F.lane;
    {   const float inv = 1.0f / l1;
#pragma unroll
        for (int c = 0; c < 4; ++c)
#pragma unroll
            for (int rr = 0; rr < 4; ++rr) { f32x4 v; v.x = o1[c][4 * rr] * inv; v.y = o1[c][4 * rr + 1] * inv; v.z = o1[c][4 * rr + 2] * inv; v.w = o1[c][4 * rr + 3] * inv; park[(4 * c + rr) * 64] = v; } }
    asm volatile("" ::: "memory");
    attn_pass<4, 4, false>(L, Kg, Vg, Ql + 64, 4, 0, 0, nkeys / 64, qpos, wq_min, wq_min + 31, 0, C2, o2, m2, l2);
    l2 += __shfl_xor(l2, 32);
    int t2 = threadIdx.x; asm volatile("" : "+v"(t2));
    const int lane2 = t2 & 63, wave2 = __builtin_amdgcn_readfirstlane(t2 >> 6), hi2 = lane2 >> 5, qpos2 = 256 * qb + 32 * wave2 + (lane2 & 31);
    const f32x4* park2 = (const f32x4*)(F.ws + WS_OSCR) + ((size_t)(blockIdx.x * NWAVES + wave2) * 16) * 64 + lane2;
#pragma unroll
    for (int c = 0; c < 4; ++c)
#pragma unroll
        for (int rr = 0; rr < 4; ++rr) { const f32x4 v = park2[(4 * c + rr) * 64]; o1[c][4 * rr] = v.x; o1[c][4 * rr + 1] = v.y; o1[c][4 * rr + 2] = v.z; o1[c][4 * rr + 3] = v.w; }
    {   const float lam_init = 0.8f - 0.6f * __expf(-0.3f * (float)layer);
        float lam;
        {   const float* lq1 = F.a->in[I_LQ1] + 64 * layer; const float* lk1 = F.a->in[I_LK1] + 64 * layer; const float* lq2 = F.a->in[I_LQ2] + 64 * layer; const float* lk2 = F.a->in[I_LK2] + 64 * layer;
            const float s1 = wave_sum(lq1[lane2] * lk1[lane2]), s2 = wave_sum(lq2[lane2] * lk2[lane2]);
            lam = __expf(s1) - __expf(s2) + lam_init; }
        const float sc = lam / l2; float ss = 0.f;
#pragma unroll
        for (int c = 0; c < 4; ++c)
#pragma unroll
            for (int r = 0; r < 16; ++r) { const float d = o1[c][r] - sc * o2[c][r]; o1[c][r] = d; ss += d * d; }
        ss += __shfl_xor(ss, 32);
        const float rn = rsqrtf(ss * (1.f / 128.f) + RMS_EPS) * (1.f - lam_init);
        const float* sg = F.a->in[I_SUBLN] + 128 * layer + 4 * hi2;
#pragma unroll
        for (int c = 0; c < 4; ++c)
#pragma unroll
            for (int rr = 0; rr < 4; ++rr) { const f32x4 g = *(const f32x4*)(sg + 32 * c + 8 * rr);
#pragma unroll
                for (int e = 0; e < 4; ++e) o1[c][4 * rr + e] *= rn * g[e]; } }
    store_o<4>((bf16*)(F.ws + WS_Y), (size_t)b * SEQ + qpos2, 128 * h, hi2, o1);
}

__device__ __forceinline__ void unit_C(Frame& F, int b, int h, int qb) {
    LAS unsigned char* L = F.lds + RING_OFF;
    const bf16* Z = (const bf16*)(F.ws + WS_Z); bf16* Y = (bf16*)(F.ws + WS_Y);
    const int hi = F.lane >> 5, l31 = F.lane & 31, q0 = 256 * qb, wq_min = q0 + 32 * F.wave, qpos = wq_min + l31;
    const size_t rb = (size_t)b * SEQ;
    LAS float* bias = (LAS float*)(L + MX_BIAS); LAS float* wtot = (LAS float*)(L + MX_SCR);
    const float L2E = opq(LOG2E);
    const int nkeys = q0 + 256;
    {
        const float* lf = (const float*)(F.ws + WS_LOGF) + rb * 4 + h;
        float v[8]; const int i0 = 8 * F.tid;
#pragma unroll
        for (int e = 0; e < 8; ++e) v[e] = (i0 + e < nkeys) ? lf[(size_t)(i0 + e) * 4] : 0.f;
#pragma unroll
        for (int e = 1; e < 8; ++e) v[e] += v[e - 1];
        float x = v[7];
#pragma unroll
        for (int o = 1; o < 64; o <<= 1) { const float t = __shfl_up(x, o); if (F.lane >= o) x += t; }
        if (F.lane == 63) wtot[F.wave] = x;
        __syncthreads();
        float woff = 0.f;
        for (int w = 0; w < F.wave; ++w) woff += wtot[w];
        const float base = woff + (x - v[7]);
#pragma unroll
        for (int e = 0; e < 8; ++e) if (i0 + e < nkeys) bias[i0 + e] = -(base + v[e]) * L2E;
    }
    const bf16* Kg = Z + rb * ZP + ZC_CK + 128 * h; const bf16* Vg = Z + rb * ZP + ZC_CV + 128 * h;
    const bf16* Ql = Z + (rb + qpos) * ZP + ZC_CQ + 128 * h;
    const float C2 = 0.08838834764831845f * L2E;
    f32x16 o[4]; float m, l;
    attn_pass<8, 4, false>(L, Kg, Vg, Ql, 0, 0, 0, nkeys / 64, qpos, wq_min, wq_min + 31, 0, C2, o, m, l);
    l += __shfl_xor(l, 32);
    {   const float inv = 1.0f / l;
#pragma unroll
        for (int c = 0; c < 4; ++c)
#pragma unroll
            for (int r = 0; r < 16; ++r) o[c][r] *= inv; }
    store_o<4>(Y, rb + qpos, 1024 + 128 * h, hi, o);
}

__device__ __forceinline__ void unit_D(Frame& F, int layer, int b, int hq, int qb) {
    LAS unsigned char* L = F.lds + RING_OFF;
    const bf16* Z = (const bf16*)(F.ws + WS_Z); bf16* Y = (bf16*)(F.ws + WS_Y);
    const int hi = F.lane >> 5, l31 = F.lane & 31, q0 = 256 * qb, wq_min = q0 + 32 * F.wave, qpos = wq_min + l31, kv = hq >> 2;
    const size_t rb = (size_t)b * SEQ;
    const float L2E = opq(LOG2E);
    const float slope2 = exp2f(-(float)(hq + 1)) * L2E;
    LAS float* bias = (LAS float*)(L + MX_BIAS);
    const int k_lo = (q0 >= 128) ? q0 - 128 : 0, nkeys = q0 + 256 - k_lo;
    for (int i = F.tid; i < nkeys; i += NTHREADS) bias[i] = slope2 * (float)(k_lo + i - q0);
    const bf16* Kg = Z + rb * ZP + ZC_DK; const bf16* Vg = Z + rb * ZP + ZC_DV;
    const bf16* Ql = Z + (rb + qpos) * ZP + ZC_DQ + 64 * hq;
    const float C2 = 0.125f * L2E;
    f32x16 o[2]; float m, l;
    attn_pass<4, 2, true>(L, Kg, Vg, Ql, 4 * kv, 2 * kv, k_lo / 64, (q0 + 256) / 64, qpos, wq_min, wq_min + 31, k_lo, C2, o, m, l);
    l += __shfl_xor(l, 32);
    {   const float sink2 = F.a->in[I_SINKS][8 * layer + hq] * L2E;
        const float inv = 1.0f / (l + __builtin_amdgcn_exp2f(sink2 - m + slope2 * (float)(qpos - q0)));
#pragma unroll
        for (int c = 0; c < 2; ++c)
#pragma unroll
            for (int r = 0; r < 16; ++r) o[c][r] *= inv; }
    store_o<2>(Y, rb + qpos, 1536 + 64 * hq, hi, o);
}


__device__ __forceinline__ float gelu_tanh(float x) { const float u = 0.7978845608028654f * (x + 0.044715f * x * x * x); const float t = 1.f - 2.f / (1.f + __expf(2.f * u)); return 0.5f * x * (1.f + t); }
__device__ __forceinline__ float neg_expm1(float x) {
    const float p = x * (1.f + x * (0.5f + x * (0.16666667f + x * (0.041666668f + x * (0.008333334f + x * (0.0013888889f + x * (0.0001984127f + x * 0.0000248016f)))))));
    return (x > -0.35f) ? -p : (1.f - __expf(x));
}
__device__ __forceinline__ void unit_B(Frame& F, int layer, int b, int n) {
    LAS unsigned char* L = F.lds + RING_OFF;
    const bf16* Z = (const bf16*)(F.ws + WS_Z); bf16* Y = (bf16*)(F.ws + WS_Y);
    LAS float* XC = (LAS float*)(L + LR_XC); LAS float* AA = (LAS float*)(L + LR_A); LAS float* UU = (LAS float*)(L + LR_U);
    LAS bf16* WT = (LAS bf16*)(L + LR_WT); LAS float* SEGA = (LAS float*)(L + LR_SEGA); LAS float* SEGH = (LAS float*)(L + LR_SEGH); LAS float* CARRY = (LAS float*)(L + LR_CARRY);
    const int tid = F.tid, lane = F.lane, wave = F.wave, hi = lane >> 5, l31 = lane & 31;
    const size_t rb = (size_t)b * SEQ;
    const int ch0 = 64 * n;
    {   const float* wa = F.a->in[I_WA] + ((size_t)layer * 8 + n) * 4096; const float* wx = F.a->in[I_WX] + ((size_t)layer * 8 + n) * 4096;
        for (int i = tid; i < 8192; i += NTHREADS) { const int which = i >> 12, q = i & 4095, c = q >> 6, d = q & 63;
            const float v = which ? wx[q] : wa[q]; WT[(64 * which + d) * 72 + c] = (bf16)(cvtpk(v, 0.f) & 0xffffu); } }
    if (tid < 128) CARRY[tid] = 0.f;
    const int sc = tid & 63, seg = tid >> 6;
    float cw[4];
#pragma unroll
    for (int j = 0; j < 4; ++j) cw[j] = F.a->in[I_CONV_W][((size_t)layer * 4 + j) * 512 + ch0 + sc];
    const float cb = F.a->in[I_CONV_B][layer * 512 + ch0 + sc];
    const int tb = wave >> 1, chh = wave & 1;
    float k_ba[16], k_bx[16], k_sp[16];
#pragma unroll
    for (int r = 0; r < 16; ++r) { const int c = ch0 + 32 * chh + (r & 3) + 8 * (r >> 2) + 4 * hi;
        k_ba[r] = F.a->in[I_BA][layer * 512 + c]; k_bx[r] = F.a->in[I_BX][layer * 512 + c];
        k_sp[r] = ((const float*)(F.ws + WS_LRUK))[layer * 512 + c]; }
    __syncthreads();
    const bf16* bxp = Z + rb * ZP + ZC_BX + ch0 + sc;
    const bf16* bgp = Z + rb * ZP + ZC_BG + ch0 + sc;
    bf16* yp = Y + rb * DM + 512 + ch0 + sc;
    for (int tile = 0; tile < SEQ / 128; ++tile) {
        const int t0 = 128 * tile;
        {   float xv[19];
#pragma unroll
            for (int j = 0; j < 19; ++j) { const int t = t0 + 16 * seg - 3 + j; xv[j] = (t >= 0) ? bf2f(bxp[(size_t)t * ZP]) : 0.f; }
#pragma unroll
            for (int j = 0; j < 16; ++j) XC[(16 * seg + j) * LR_P + sc] = cb + cw[0] * xv[j] + cw[1] * xv[j + 1] + cw[2] * xv[j + 2] + cw[3] * xv[j + 3]; }
        float gbv[16];
#pragma unroll
        for (int j = 0; j < 16; ++j) gbv[j] = bf2f(bgp[(size_t)(t0 + 16 * seg + j) * ZP]);
        __syncthreads();
        {   f32x16 dr, di;
#pragma unroll
            for (int r = 0; r < 16; ++r) { dr[r] = 0.f; di[r] = 0.f; }
            const LAS float* xrow = XC + (32 * tb + l31) * LR_P + 8 * hi;
#pragma unroll
            for (int s = 0; s < 4; ++s) {
                const f32x4 x0 = *(const LAS f32x4*)(xrow + 16 * s), x1 = *(const LAS f32x4*)(xrow + 16 * s + 4);
                v4u xw; xw.x = cvtpk(x0.x, x0.y); xw.y = cvtpk(x0.z, x0.w); xw.z = cvtpk(x1.x, x1.y); xw.w = cvtpk(x1.z, x1.w);
                const bf16x8 xf = __builtin_bit_cast(bf16x8, xw);
                const bf16x8 wr_ = *(const LAS bf16x8*)(WT + (32 * chh + l31) * 72 + 16 * s + 8 * hi);
                const bf16x8 wi_ = *(const LAS bf16x8*)(WT + (64 + 32 * chh + l31) * 72 + 16 * s + 8 * hi);
                dr = __builtin_amdgcn_mfma_f32_32x32x16_bf16(wr_, xf, dr, 0, 0, 0);
                di = __builtin_amdgcn_mfma_f32_32x32x16_bf16(wi_, xf, di, 0, 0, 0);
            }
            const int trow = 32 * tb + l31;
#pragma unroll
            for (int rr = 0; rr < 4; ++rr) { const int cc = 32 * chh + 8 * rr + 4 * hi;
                const f32x4 xc4 = *(const LAS f32x4*)(XC + trow * LR_P + cc);
                f32x4 a4, u4;
#pragma unroll
                for (int e = 0; e < 4; ++e) { const int r = 4 * rr + e;
                    const float rg = 1.f / (1.f + __expf(-(dr[r] + k_ba[r]))), ig = 1.f / (1.f + __expf(-(di[r] + k_bx[r])));
                    const float la = rg * k_sp[r];
                    a4[e] = __expf(la); u4[e] = sqrtf(neg_expm1(2.f * la)) * (ig * xc4[e]); }
                *(LAS f32x4*)(AA + trow * LR_P + cc) = a4; *(LAS f32x4*)(UU + trow * LR_P + cc) = u4; }
        }
        __syncthreads();
        float av[16], uv[16];
        {   float hl = 0.f, ap = 1.f;
#pragma unroll
            for (int j = 0; j < 16; ++j) { av[j] = AA[(16 * seg + j) * LR_P + sc]; uv[j] = UU[(16 * seg + j) * LR_P + sc]; hl = av[j] * hl + uv[j]; ap *= av[j]; }
            SEGA[seg * 64 + sc] = ap; SEGH[seg * 64 + sc] = hl; }
        __syncthreads();
        {   float h = CARRY[(tile & 1) * 64 + sc];
            for (int s = 0; s < seg; ++s) h = SEGA[s * 64 + sc] * h + SEGH[s * 64 + sc];
#pragma unroll
            for (int j = 0; j < 16; ++j) { h = av[j] * h + uv[j];
                yp[(size_t)(t0 + 16 * seg + j) * DM] = (bf16)(cvtpk(gelu_tanh(gbv[j]) * h, 0.f) & 0xffffu); }
            if (seg == 7) CARRY[((tile + 1) & 1) * 64 + sc] = h; }
    }
    __syncthreads();
}

constexpr int MXN_B = 32, MXN_AC = 512, MXN_D = 512, MX_ITEMS = MXN_B + MXN_AC + MXN_D;
__device__ __forceinline__ void mixer_phase(Frame& F, int layer) {
    LAS unsigned* itemw = (LAS unsigned*)(F.lds + LDSCTL_OFF);
    for (;;) {
        __syncthreads();
        if (F.tid == 0) *itemw = __hip_atomic_fetch_add((unsigned*)(F.ctl + CW_Q + 64 * layer), 1u, __ATOMIC_RELAXED, __HIP_MEMORY_SCOPE_AGENT);
        __syncthreads();
        const int it = __builtin_amdgcn_readfirstlane((int)*itemw);
        if (it >= MX_ITEMS) break;
        { int t_ = threadIdx.x; asm volatile("" : "+v"(t_)); F.tid = t_; F.lane = t_ & 63; F.wave = __builtin_amdgcn_readfirstlane(t_ >> 6); }
        if (it < MXN_B) {
#ifndef NO_B
            unit_B(F, layer, it >> 3, it & 7);
#endif
        }
        else if (it < MXN_B + MXN_AC) { const int r = it - MXN_B, qb = 15 - (r >> 5), w = r & 31;
            if (w < 16) {
#ifndef NO_A
                unit_A(F, layer, w >> 2, w & 3, qb);
#endif
            } else {
#ifndef NO_C
                unit_C(F, (w - 16) >> 2, (w - 16) & 3, qb);
#endif
            } }
        else { const int r = it - MXN_B - MXN_AC, qb = 15 - (r >> 5), w = r & 31;
#ifndef NO_D
            unit_D(F, layer, w >> 3, w & 7, qb);
#endif
        }
    }
}


#ifndef MK_SPLIT
#define MK_SPLIT 1
#endif
constexpr int NPHASES = 2 + 8 * DEPTH;
__global__ void __launch_bounds__(NTHREADS, 2) mk_fwd(Args args) {
    extern __shared__ __attribute__((aligned(16))) unsigned char lds[];
    Frame F;
    F.lds = (LAS unsigned char*)lds;
    F.tid = threadIdx.x; F.lane = F.tid & 63; F.wave = __builtin_amdgcn_readfirstlane(F.tid >> 6);
    F.G = gridDim.x; { const int bx = blockIdx.x; F.vcu = (F.G % 8 == 0) ? (bx % 8) * (F.G / 8) + bx / 8 : bx; }
    F.ws = args.ws; F.ctl = (gu32*)(args.ws + WS_CTL); F.out = args.out;
    F.a = &args;
    for (int u = F.tid; u < (LDS_BYTES - LDSCTL_OFF) / 4; u += NTHREADS) ((LAS unsigned*)(F.lds + LDSCTL_OFF))[u] = 0u;
    __syncthreads();
    volatile LAS unsigned* MISC = (volatile LAS unsigned*)(F.lds + MISC_OFF);
    XcdBarrier bar; bar.bar = (unsigned*)(F.ctl + CW_BAR); bar.x = 0; bar.st = nullptr;
    if (!MK_SPLIT) bar = xcd_barrier_post((unsigned*)(F.ctl + CW_BAR), MISC + 8);
    const int lo = args.ph_lo, hi = args.ph_hi;
#ifndef ONLY
#define ONLY -1
#endif
#define ON(j) (ONLY < 0 || ONLY == (j))
#define IN(k) (lo <= (k) && (k) < hi)
#define SEAM(k) do { if (IN(k) && IN((k) + 1)) { XcdBarrier b_ = bar; asm volatile("" : "+s"(b_.bar), "+s"(b_.x)); xcd_barrier(b_); } } while (0)

    float* H = (float*)(F.ws + WS_H); bf16* U = (bf16*)(F.ws + WS_U); bf16* Zb = (bf16*)(F.ws + WS_Z); bf16* Gb = (bf16*)(F.ws + WS_G);
    bf16* Yb = (bf16*)(F.ws + WS_Y); bf16* MIXb = (bf16*)(F.ws + WS_MIX); bf16* HID = (bf16*)(F.ws + WS_G);

    if constexpr (ON(10)) if (IN(0)) { p0_weights(F); } SEAM(0);
    if constexpr (ON(11)) if (IN(1)) { norm_phase<1>(F, F.a->in[I_X], F.a->in[I_NORM_MIX], U, nullptr, 0); } SEAM(1);

#ifdef UNROLL_LAYERS
#pragma unroll
#endif
    for (int layer = 0; layer < DEPTH; ++layer) {
        const int pb = 2 + 8 * layer;
#define REFRESH() do { int t_ = threadIdx.x; asm volatile("" : "+v"(t_)); F.tid = t_; F.lane = t_ & 63; F.wave = __builtin_amdgcn_readfirstlane(t_ >> 6); } while (0)
        unsigned char* wl = F.ws + WS_W + (size_t)layer * W_LAYER;
        if constexpr (ON(0)) if (IN(pb + 0)) {
            pg8::Gemm g{U, (const bf16*)(wl + WO_IN), M, NIN, DM}; pg8::StaticOrder S; S.init(M, NIN, F.G, (int)blockIdx.x);
            pg8::EpiZ E{Zb, Gb, F.a->in[I_B_GATE] + (size_t)layer * GP};
            pg8::gemm_phase<pg8::EpiZ, pg8::StaticOrder, true, true>(F.lds + RING_OFF, g, S, E);
        }
        SEAM(pb + 0);
#ifndef NO_MIX
        if constexpr (ON(1)) if (IN(pb + 1)) { REFRESH(); mixer_phase(F, layer); }
#endif
        SEAM(pb + 1);
        if constexpr (ON(2)) if (IN(pb + 2)) {
            pg8::Gemm g{Yb, (const bf16*)(wl + WO_BR), M, DM, DM}; pg8::StaticOrder S; S.init(M, DM, F.G, (int)blockIdx.x);
            pg8::EpiMix E{Gb, MIXb};
            pg8::gemm_phase<pg8::EpiMix, pg8::StaticOrder, true, true>(F.lds + RING_OFF, g, S, E);
        }
        SEAM(pb + 2);
        if constexpr (ON(3)) if (IN(pb + 3)) {
            pg8::Gemm g{MIXb, (const bf16*)(wl + WO_OUT), M, DM, DM}; pg8::StaticOrder S; S.init(M, DM, F.G, (int)blockIdx.x);
            pg8::EpiResid E{layer == 0 ? F.a->in[I_X] : (const float*)H, H};
            pg8::gemm_phase<pg8::EpiResid, pg8::StaticOrder, true, true>(F.lds + RING_OFF, g, S, E);
        }
        SEAM(pb + 3);
        if constexpr (ON(4)) if (IN(pb + 4)) { REFRESH(); norm_phase<0>(F, H, F.a->in[I_NORM_FFN] + (size_t)layer * DM, U, nullptr, layer); }
        SEAM(pb + 4);
        if constexpr (ON(5)) if (IN(pb + 5)) {
            pg8::Gemm g{U, (const bf16*)(wl + WO_GU), M, NGU, DM}; pg8::StaticOrder S; S.init(M, NGU, F.G, (int)blockIdx.x);
            pg8::EpiSwiGLU E{HID};
            pg8::gemm_phase<pg8::EpiSwiGLU, pg8::StaticOrder, true, true>(F.lds + RING_OFF, g, S, E);
        }
        SEAM(pb + 5);
        if constexpr (ON(6)) if (IN(pb + 6)) {
            pg8::Gemm g{HID, (const bf16*)(wl + WO_DN), M, DM, DFF}; pg8::StaticOrder S; S.init(M, DM, F.G, (int)blockIdx.x);
            pg8::EpiResid E{H, H};
            pg8::gemm_phase<pg8::EpiResid, pg8::StaticOrder, true, true>(F.lds + RING_OFF, g, S, E);
        }
        SEAM(pb + 6);
        if constexpr (ON(7)) if (IN(pb + 7)) { REFRESH();
            if (layer + 1 < DEPTH) norm_phase<1>(F, H, F.a->in[I_NORM_MIX] + (size_t)(layer + 1) * DM, U, nullptr, layer + 1);
            else norm_phase<2>(F, H, F.a->in[I_NORM_FINAL], nullptr, F.out, 0);
        }
        if (layer + 1 < DEPTH) SEAM(pb + 7);
    }
#undef IN
#undef SEAM
}

#ifndef DBG_STOP
#define DBG_STOP -1
#endif
#ifndef DBG_SRC
#define DBG_SRC 0
#endif
#ifndef DBG_COL
#define DBG_COL 0
#endif
__global__ void dbg_dump(const unsigned char* ws, float* out) {
    const size_t i = (size_t)blockIdx.x * blockDim.x + threadIdx.x; if (i >= (size_t)M * DM) return;
    const size_t r = i / DM, c = i % DM; float v;
    if (DBG_SRC == 0) v = bf2f(((const bf16*)(ws + WS_Y))[i]);
    else if (DBG_SRC == 1) v = bf2f(((const bf16*)(ws + WS_Z))[r * ZP + DBG_COL + c]);
    else if (DBG_SRC == 2) v = ((const float*)(ws + WS_H))[i];
    else if (DBG_SRC == 3) v = bf2f(((const bf16*)(ws + WS_MIX))[i]);
    else if (DBG_SRC == 4) v = bf2f(((const bf16*)(ws + WS_G))[r * GP + DBG_COL + c]);
    else v = bf2f(((const bf16*)(ws + WS_U))[i]);
    out[i] = v;
}
extern "C" void kernel_launch(void* const* d_in, const int* in_sizes, int n_in, void* d_out, int out_size, void* d_ws, size_t ws_size, hipStream_t stream) {
    static int grid = 0;
    if (grid == 0) {
        if (n_in != 25 || in_sizes[0] != M * DM || out_size != M * DM || ws_size < WS_END) { fprintf(stderr, "kernel_launch: unexpected shapes (n_in %d, in0 %d, out %d, ws %zu); nothing launched\n", n_in, n_in > 0 ? in_sizes[0] : -1, out_size, ws_size); grid = -1; return; }
        int dev = 0, cus = 0, per_cu = 0;
        if (hipGetDevice(&dev) != hipSuccess || hipDeviceGetAttribute(&cus, hipDeviceAttributeMultiprocessorCount, dev) != hipSuccess) { grid = -1; return; }
        if (hipFuncSetAttribute((const void*)mk_fwd, hipFuncAttributeMaxDynamicSharedMemorySize, LDS_BYTES) != hipSuccess) { fprintf(stderr, "kernel_launch: hipFuncSetAttribute failed\n"); grid = -1; return; }
        if (hipOccupancyMaxActiveBlocksPerMultiprocessor(&per_cu, (const void*)mk_fwd, NTHREADS, LDS_BYTES) != hipSuccess || per_cu < 1) { fprintf(stderr, "kernel_launch: occupancy query says %d workgroups per CU\n", per_cu); }
        (void)hipGetLastError();
        grid = cus;
    }
    if (grid < 0) return;
    if (hipMemsetAsync((char*)d_ws + WS_CTL, 0, CTL_ZERO_BYTES, stream) != hipSuccess) return;
    Args a{};
    for (int i = 0; i < 25; ++i) a.in[i] = (const float*)d_in[i];
    a.out = (float*)d_out; a.ws = (unsigned char*)d_ws;
#if MK_SPLIT
    for (int p = 0; p < NPHASES; ++p) { if (DBG_STOP >= 0 && p > DBG_STOP) break; a.ph_lo = p; a.ph_hi = p + 1; hipLaunchKernelGGL(mk_fwd, dim3(grid), dim3(NTHREADS), LDS_BYTES, stream, a); }
    if (DBG_STOP >= 0) hipLaunchKernelGGL(dbg_dump, dim3((M * DM + 255) / 256), dim3(256), 0, stream, (const unsigned char*)d_ws, (float*)d_out);
#else
    a.ph_lo = 0; a.ph_hi = NPHASES;
    hipLaunchKernelGGL(mk_fwd, dim3(grid), dim3(NTHREADS), LDS_BYTES, stream, a);
#endif
    const hipError_t le = hipPeekAtLastError();
    if (le != hipSuccess) fprintf(stderr, "kernel_launch: launch failed: %s\n", hipGetErrorName(le));
}
```

```cpp
#include <hip/hip_runtime.h>
#include <cstdio>
#include <cstdint>
namespace pg8 {
#define PG8_LAS __attribute__((address_space(3)))
typedef unsigned short bf16_t;
typedef short bf16x8 __attribute__((ext_vector_type(8)));
typedef float f32x4 __attribute__((ext_vector_type(4)));
typedef unsigned u32x4 __attribute__((ext_vector_type(4)));
constexpr int BM = 256, BK = 64, HALF = 128, HTB = HALF * BK * 2  , STAGE_BYTES = 8 * HTB, NXCD = 8, WGM = 8;

__host__ __device__ __forceinline__ int lds_byte(int r, int c) { const int st = (r >> 4) * 2 + (c >> 5), rr = r & 15, cc = c & 31, ob = rr * 64 + cc * 2; return st * 1024 + (ob ^ (((ob >> 9) & 1) << 5)); }
__host__ __device__ __forceinline__ void stage_rc(int b, int& R, int& C) { const int st = b / 1024, sb = b % 1024, swz = sb ^ (((sb >> 9) & 1) << 5); R = (st >> 1) * 16 + swz / 64; C = (st & 1) * 32 + (swz % 64) / 2; }
__host__ __device__ __forceinline__ size_t img_a(int row, int col, int nkt) { return ((((size_t)(row >> 8) * nkt + (col >> 6)) * 2 + ((row >> 7) & 1)) << 14) + (size_t)lds_byte(row & 127, col & 63); }
__host__ __device__ __forceinline__ int perm32(int rho) { const int n = rho >> 4, i = rho & 15; return 8 * (i >> 2) + 4 * n + (i & 3); }

struct Unit { int pm, pn; };
struct Gemm { const bf16_t* A; const bf16_t* Bt; int M, N, K; };

struct StaticOrder {
    int nM, nN, nwg, G, c;
    __host__ __device__ void init(int M, int N, int G_, int c_) { nM = M / BM; nN = N / BM; nwg = nM * nN; G = G_; c = c_; }
    __host__ __device__ bool next(int i, Unit& u) const {
        const long L = (long)i * G + c; if (L >= nwg) return false;
        int wgid = (int)L; { const int q = nwg / NXCD, r = nwg % NXCD, xcd = wgid % NXCD, off = wgid / NXCD; wgid = (xcd < r ? xcd * (q + 1) : r * (q + 1) + (xcd - r) * q) + off; }
        const int nig = WGM * nN, gid = wgid / nig, fm = gid * WGM, gsz = (nM - fm) < WGM ? (nM - fm) : WGM;
        u.pm = fm + ((wgid % nig) % gsz); u.pn = (wgid % nig) / gsz; return true;
    }
    __device__ __forceinline__ void a_ready(const Unit&) const {}
    __device__ __forceinline__ void done(const Unit&) const {}
};

typedef float f32x2c __attribute__((ext_vector_type(2))); typedef __bf16 bf16x2c __attribute__((ext_vector_type(2)));
__device__ __forceinline__ unsigned cvt_pk_bf16(float lo, float hi) { f32x2c v = {lo, hi}; bf16x2c b = __builtin_convertvector(v, bf16x2c); return __builtin_bit_cast(unsigned, b); }
typedef float f32x2 __attribute__((ext_vector_type(2)));

#ifndef DBG_EPI2
#define DBG_EPI2 0
#endif
typedef unsigned u32x2v __attribute__((ext_vector_type(2)));
__device__ __forceinline__ float sigmoid_f(float x, float nl2e) { return __builtin_amdgcn_rcpf(1.0f + __builtin_amdgcn_exp2f(nl2e * x)); }
#define PG8_NL2E(v) float v = -1.4426950408889634f; asm volatile("" : "+v"(v))

__device__ __forceinline__ void bf8_to_f32(const u32x4 w, float (&f)[8]) {
    f[0] = __builtin_bit_cast(float, w.x << 16); f[1] = __builtin_bit_cast(float, w.x & 0xffff0000u);
    f[2] = __builtin_bit_cast(float, w.y << 16); f[3] = __builtin_bit_cast(float, w.y & 0xffff0000u);
    f[4] = __builtin_bit_cast(float, w.z << 16); f[5] = __builtin_bit_cast(float, w.z & 0xffff0000u);
    f[6] = __builtin_bit_cast(float, w.w << 16); f[7] = __builtin_bit_cast(float, w.w & 0xffff0000u);
}
struct EpiZ {
    static constexpr bool PERM = true, AFTER_DRAIN = false, EPI2 = false; static constexpr int KSEG = 0;
    bf16_t* Z;
    __device__ __forceinline__ void operator()(const f32x4 (&acc)[2][2][4][2], const Unit& u, int wr, int wc, int fr, int fq) const {
        const int row0 = u.pm * BM + wr * 64 + fr, col0 = u.pn * BM + wc * 32 + 8 * fq;
#pragma unroll
        for (int ai = 0; ai < 2; ++ai)
#pragma unroll
            for (int m = 0; m < 4; ++m) { bf16_t* rowp = Z + ((size_t)(2 * u.pn) * 16384 + (size_t)(row0 + ai * HALF + m * 16)) * 128 + (col0 & 127);
#pragma unroll
                for (int bj = 0; bj < 2; ++bj) { const f32x4 v0 = acc[ai][bj][m][0], v1 = acc[ai][bj][m][1];
                    u32x4 w; w.x = cvt_pk_bf16(v0[0], v0[1]); w.y = cvt_pk_bf16(v0[2], v0[3]); w.z = cvt_pk_bf16(v1[0], v1[1]); w.w = cvt_pk_bf16(v1[2], v1[3]);
                    *(u32x4*)(rowp + (size_t)bj * 16384 * 128) = w; } }
    }
};
struct EpiG {
    static constexpr bool PERM = true, AFTER_DRAIN = false, EPI2 = (DBG_EPI2 == 1); static constexpr int KSEG = 0;
    bf16_t* G; const float* bgate; float sc;
    __device__ __forceinline__ void operator()(const f32x4 (&acc)[2][2][4][2], const Unit& u, int wr, int wc, int fr, int fq) const {
        {   unsigned ones_ = ~0u; asm volatile("" : "+s"(ones_));
            const int ln_ = (int)__builtin_amdgcn_mbcnt_hi(ones_, __builtin_amdgcn_mbcnt_lo(ones_, 0u)); fr = ln_ & 15; fq = ln_ >> 4; }
        const int oc = u.pn * 64 + wc * 16 + 4 * fq;
        bf16_t* gfr = G + ((size_t)(u.pm * 8 + (u.pn >> 2)) * 4) * 65536 + 8 * ((((u.pn >> 1) & 1) * 512 + wr * 256 + (2 * (u.pn & 1) + (wc >> 1)) * 64) + 16 * (2 * (wc & 1) + (fq >> 1)) + fr);
        PG8_NL2E(nl2e);
        f32x4 bv[4];
#pragma unroll
        for (int k = 0; k < 4; ++k) bv[k] = *(const f32x4*)(bgate + k * 2048 + oc) * nl2e;
#pragma unroll
        for (int ai = 0; ai < 2; ++ai)
#pragma unroll
            for (int m = 0; m < 4; ++m) {
                float sc_ = sc * nl2e; asm volatile("" : "+v"(sc_));
                f32x4 d[4], g[4];
#pragma unroll
                for (int k = 0; k < 4; ++k) { const f32x4 x = acc[ai][k >> 1][m][k & 1] * sc_ + bv[k];
#pragma unroll
                    for (int e = 0; e < 4; ++e) { d[k][e] = fminf(1.0f + __builtin_amdgcn_exp2f(x[e]), 1e30f); g[k][e] = __builtin_amdgcn_rcpf(d[k][e]); } }
                u32x2v w[4];
#pragma unroll
                for (int k = 0; k < 4; ++k) { const f32x4 o = (k < 3) ? g[k] * d[k < 3 ? k + 1 : 3] : g[3]; w[k].x = cvt_pk_bf16(o[0], o[1]); w[k].y = cvt_pk_bf16(o[2], o[3]); }
#pragma unroll
                for (int q = 0; q < 2; ++q) {
                    const auto r0 = __builtin_amdgcn_permlane16_swap(w[2 + q].x, w[q].x, false, false), r1 = __builtin_amdgcn_permlane16_swap(w[2 + q].y, w[q].y, false, false);
                    u32x4 v; v.x = r0[0]; v.y = r1[0]; v.z = r0[1]; v.w = r1[1];
                    *(u32x4*)(gfr + (size_t)((fq & 1) ? q : 2 + q) * 65536 + (ai * 4 + m) * 8192) = v;
                    if (q == 1) asm volatile("" :: "v"(v.x), "v"(v.y), "v"(v.z), "v"(v.w) : "memory"); } }
    }
};

struct EpiResid {
    static constexpr bool PERM = true, AFTER_DRAIN = false, EPI2 = false; static constexpr int KSEG = 0;
    const float* srcx; bf16_t* H;
    __device__ __forceinline__ void operator()(const f32x4 (&acc)[2][2][4][2], const Unit& u, int wr, int wc, int fr, int fq) const {
        const int row0 = u.pm * BM + wr * 64 + fr, col0 = u.pn * BM + wc * 32 + 8 * fq;
#pragma unroll
        for (int ai = 0; ai < 2; ++ai) {
            f32x4 r[4][2][2];
            if (srcx) {
#pragma unroll
                for (int m = 0; m < 4; ++m) { const size_t off = (size_t)(row0 + ai * HALF + m * 16) * 2048 + col0;
#pragma unroll
                    for (int bj = 0; bj < 2; ++bj)
#pragma unroll
                        for (int n = 0; n < 2; ++n) r[m][bj][n] = *(const f32x4*)(srcx + off + bj * HALF + 4 * n); }
            } else {
                u32x4 hb[4][2];
#pragma unroll
                for (int m = 0; m < 4; ++m)
#pragma unroll
                    for (int bj = 0; bj < 2; ++bj) hb[m][bj] = *(const u32x4*)((const char*)H + img_a(row0 + ai * HALF + m * 16, col0 + bj * HALF, 32));
#pragma unroll
                for (int m = 0; m < 4; ++m)
#pragma unroll
                    for (int bj = 0; bj < 2; ++bj) { float f[8]; bf8_to_f32(hb[m][bj], f);
                        r[m][bj][0] = (f32x4){f[0], f[1], f[2], f[3]}; r[m][bj][1] = (f32x4){f[4], f[5], f[6], f[7]}; }
            }
#pragma unroll
            for (int m = 0; m < 4; ++m)
#pragma unroll
                for (int bj = 0; bj < 2; ++bj) { const f32x4 v0 = r[m][bj][0] + acc[ai][bj][m][0], v1 = r[m][bj][1] + acc[ai][bj][m][1];
                    u32x4 w; w.x = cvt_pk_bf16(v0[0], v0[1]); w.y = cvt_pk_bf16(v0[2], v0[3]); w.z = cvt_pk_bf16(v1[0], v1[1]); w.w = cvt_pk_bf16(v1[2], v1[3]);
                    *(u32x4*)((char*)H + img_a(row0 + ai * HALF + m * 16, col0 + bj * HALF, 32)) = w; }
        }
    }
};

struct EpiSwiGLU {
    static constexpr bool PERM = true, AFTER_DRAIN = false, EPI2 = (DBG_EPI2 == 2); static constexpr int KSEG = 0;
    bf16_t* HID;
    __device__ __forceinline__ void operator()(const f32x4 (&acc)[2][2][4][2], const Unit& u, int wr, int wc, int fr, int fq) const {
        const int row0 = u.pm * BM + wr * 64 + fr, col0 = u.pn * HALF + wc * 32 + 8 * fq;
        PG8_NL2E(nl2e);
#pragma unroll
        for (int ai = 0; ai < 2; ++ai)
#pragma unroll
            for (int m = 0; m < 4; ++m) { bf16_t* rowp = (bf16_t*)((char*)HID + img_a(row0 + ai * HALF + m * 16, col0, 88));
                f32x4 v0, v1;
#pragma unroll
                for (int e = 0; e < 4; ++e) { const float g0 = acc[ai][0][m][0][e], g1 = acc[ai][0][m][1][e];
                    v0[e] = g0 * sigmoid_f(g0, nl2e) * acc[ai][1][m][0][e]; v1[e] = g1 * sigmoid_f(g1, nl2e) * acc[ai][1][m][1][e]; }
                u32x4 w; w.x = cvt_pk_bf16(v0[0], v0[1]); w.y = cvt_pk_bf16(v0[2], v0[3]); w.z = cvt_pk_bf16(v1[0], v1[1]); w.w = cvt_pk_bf16(v1[2], v1[3]);
                *(u32x4*)rowp = w; }
    }
};

struct EpiMix {
    static constexpr bool PERM = true, AFTER_DRAIN = false, EPI2 = (DBG_EPI2 == 3); static constexpr int KSEG = 8;
    const bf16_t* G; bf16_t* MIX;
    __device__ __forceinline__ void kseg(f32x4 (&acc)[2][2][4][2], const Unit& u, int i, int wr, int wc, int fr, int fq) const {
        asm volatile("" : "+v"(fr), "+v"(fq));
        const bf16_t* gfr = G + ((size_t)(u.pm * 8 + u.pn) * 4 + (i - 1)) * 65536 + 8 * (wr * 256 + wc * 64 + 16 * fq + fr);
        u32x4 wv[2][4][2];
#pragma unroll
        for (int ai = 0; ai < 2; ++ai)
#pragma unroll
            for (int m = 0; m < 4; ++m)
#pragma unroll
                for (int bj = 0; bj < 2; ++bj) wv[ai][m][bj] = *(const u32x4*)(gfr + (ai * 4 + m) * 8192 + bj * 4096);
#pragma unroll
        for (int ai = 0; ai < 2; ++ai) {
#pragma unroll
            for (int m = 0; m < 4; ++m)
#pragma unroll
                for (int bj = 0; bj < 2; ++bj) { float f[8]; bf8_to_f32(wv[ai][m][bj], f);
#pragma unroll
                    for (int e = 0; e < 4; ++e) { acc[ai][bj][m][0][e] *= f[e]; acc[ai][bj][m][1][e] *= f[4 + e]; } }
        }
        asm volatile("" ::: "memory");
    }
    __device__ __forceinline__ void operator()(const f32x4 (&acc)[2][2][4][2], const Unit& u, int wr, int wc, int fr, int fq) const {
        const int row0 = u.pm * BM + wr * 64 + fr, col0 = u.pn * BM + wc * 32 + 8 * fq;
        const bf16_t* gfr = G + ((size_t)(u.pm * 8 + u.pn) * 4 + 3) * 65536 + 8 * (wr * 256 + wc * 64 + 16 * fq + fr);
#pragma unroll
        for (int ai = 0; ai < 2; ++ai) {
            u32x4 wg[4][2];
#pragma unroll
            for (int m = 0; m < 4; ++m)
#pragma unroll
                for (int bj = 0; bj < 2; ++bj) wg[m][bj] = *(const u32x4*)(gfr + (ai * 4 + m) * 8192 + bj * 4096);
#pragma unroll
            for (int m = 0; m < 4; ++m) { const size_t ro = (size_t)(row0 + ai * HALF + m * 16);
#pragma unroll
                for (int bj = 0; bj < 2; ++bj) {
                    float g[8]; bf8_to_f32(wg[m][bj], g);
                    const f32x4 a0 = acc[ai][bj][m][0], a1 = acc[ai][bj][m][1];
                    u32x4 w; w.x = cvt_pk_bf16(a0[0] * g[0], a0[1] * g[1]); w.y = cvt_pk_bf16(a0[2] * g[2], a0[3] * g[3]);
                             w.z = cvt_pk_bf16(a1[0] * g[4], a1[1] * g[5]); w.w = cvt_pk_bf16(a1[2] * g[6], a1[3] * g[7]);
                    *(u32x4*)((char*)MIX + img_a((int)ro, col0 + bj * HALF, 32)) = w; } }
        }
    }
};


template <class Epi, class Sched, bool ALIGN_EPI = false, bool SP2 = false, bool FP8 = false, bool AIMG = false>
__device__ __forceinline__ void gemm_phase(PG8_LAS unsigned char* lds, const Gemm g, const Sched& S, const Epi& E, const int wv0) {
    unsigned ones_ = ~0u; asm volatile("" : "+s"(ones_));
    int tid_ = wv0 * 64 + (int)__builtin_amdgcn_mbcnt_hi(ones_, __builtin_amdgcn_mbcnt_lo(ones_, 0u)); asm volatile("" : "+v"(tid_));
    const int tid = tid_, wid = __builtin_amdgcn_readfirstlane(tid >> 6), lane = tid & 63, wr = wid >> 2, wc = wid & 3, fr = lane & 15, fq = lane >> 4;
    const int K = g.K, nt = K / BK;
    unsigned voffA[2], voffB[2];
#pragma unroll
    for (int i = 0; i < 2; ++i) { int R, C; stage_rc(tid * 16 + i * 8192, R, C); const int Rb = Epi::PERM ? ((R & ~31) + perm32(R & 31)) : R;
        voffB[i] = (unsigned)(tid * 16 + i * 8192); voffA[i] = AIMG ? voffB[i] : (unsigned)(R * K + C) * 2u; (void)Rb; }
    const size_t kstep = AIMG ? (size_t)32768 : (size_t)(BK * 2);
    const size_t hstep = AIMG ? (size_t)16384 : (size_t)HALF * K * 2;
    const size_t tstep = (size_t)nt * 32768;
    const size_t kstepB = 32768, hstepB = 16384, tstepB = (size_t)nt * 32768;
    const unsigned ldsw = (unsigned)wid * 1024u;
    const int aoff = lds_byte(wr * 64 + fr, fq * 8), boff = lds_byte(wc * 32 + fr, fq * 8);
#define PG8_SA(b, h) (((b) * 2 + (h)) * HTB)
#define PG8_SB(b, h) ((4 + (b) * 2 + (h)) * HTB)
#define PG8_STAGE(bufoff, gbase, voff) do { _Pragma("unroll") for (int _i = 0; _i < 2; ++_i) { unsigned vo_ = (voff)[_i]; if constexpr (FP8) asm volatile("" : "+v"(vo_));     \
        __builtin_amdgcn_global_load_lds((const unsigned*)((const char*)(gbase) + vo_), (PG8_LAS unsigned*)(lds + (bufoff) + ldsw + _i * 8192), 16, 0, 0); } } while (0)
#define PG8_LDA(dst, b, h) do { _Pragma("unroll") for (int m = 0; m < 4; ++m) _Pragma("unroll") for (int k = 0; k < 2; ++k) dst[m][k] = *(const PG8_LAS bf16x8*)(lds + PG8_SA(b, h) + aoff + m * 2048 + k * 1024); } while (0)
#define PG8_LDB(dst, b, h) do { _Pragma("unroll") for (int n = 0; n < 2; ++n) _Pragma("unroll") for (int k = 0; k < 2; ++k) dst[n][k] = *(const PG8_LAS bf16x8*)(lds + PG8_SB(b, h) + boff + n * 2048 + k * 1024); } while (0)
#define PG8_MMA(ai, bj, At, Bt) do { __builtin_amdgcn_s_setprio(1); _Pragma("unroll") for (int m = 0; m < 4; ++m) _Pragma("unroll") for (int n = 0; n < 2; ++n) { \
        if constexpr (FP8) { typedef int v4i_ __attribute__((ext_vector_type(4))); typedef int v8i_ __attribute__((ext_vector_type(8))); \
            const v4i_ b0_ = __builtin_bit_cast(v4i_, Bt[n][0]), b1_ = __builtin_bit_cast(v4i_, Bt[n][1]), a0_ = __builtin_bit_cast(v4i_, At[m][0]), a1_ = __builtin_bit_cast(v4i_, At[m][1]); \
            const v8i_ bb_ = (v8i_){b0_[0], b0_[1], b0_[2], b0_[3], b1_[0], b1_[1], b1_[2], b1_[3]}, aa_ = (v8i_){a0_[0], a0_[1], a0_[2], a0_[3], a1_[0], a1_[1], a1_[2], a1_[3]}; \
            acc[ai][bj][m][n] = __builtin_amdgcn_mfma_scale_f32_16x16x128_f8f6f4(bb_, aa_, acc[ai][bj][m][n], 0, 0, 0, 0x7f7f7f7f, 0, 0x7f7f7f7f); } \
        else { _Pragma("unroll") for (int k = 0; k < 2; ++k) acc[ai][bj][m][n] = __builtin_amdgcn_mfma_f32_16x16x32_bf16(Bt[n][k], At[m][k], acc[ai][bj][m][n], 0, 0, 0); } } \
        __builtin_amdgcn_s_setprio(0); } while (0)
#define PG8_WAIT_V(n) asm volatile("s_waitcnt vmcnt(" #n ")" ::: "memory")
#define PG8_WAIT_L(n) asm volatile("s_waitcnt lgkmcnt(" #n ")" ::: "memory")
#define PG8_BAR __builtin_amdgcn_s_barrier()
#define PG8_SCHED __builtin_amdgcn_sched_barrier(0)
    Unit cur, nxt; int ui = 0;
    if (!S.next(0, cur)) return;
    f32x4 acc[2][2][4][2];
#pragma unroll
    for (int a = 0; a < 2; ++a)
#pragma unroll
        for (int b = 0; b < 2; ++b)
#pragma unroll
            for (int m = 0; m < 4; ++m)
#pragma unroll
                for (int n = 0; n < 2; ++n) acc[a][b][m][n] = (f32x4){0.f, 0.f, 0.f, 0.f};
    bf16x8 At[4][2], B0[2][2], B1[2][2];
    const char* cA = (const char*)g.A + (size_t)cur.pm * tstep; const char* cB = (const char*)g.Bt + (size_t)cur.pn * tstepB;
    S.a_ready(cur);
    if constexpr (SP2) {
        PG8_STAGE(PG8_SB(0, 0), cB, voffB); PG8_STAGE(PG8_SB(0, 1), cB + hstepB, voffB); PG8_STAGE(PG8_SA(0, 0), cA, voffA); PG8_STAGE(PG8_SA(0, 1), cA + hstep, voffA);
        if (wr == 1) PG8_BAR;
        PG8_WAIT_V(2); PG8_BAR;
        PG8_STAGE(PG8_SB(1, 0), cB + kstepB, voffB); PG8_STAGE(PG8_SA(1, 0), cA + kstep, voffA); PG8_STAGE(PG8_SB(1, 1), cB + hstepB + kstepB, voffB);
        PG8_WAIT_V(6); PG8_BAR;
    } else {
        PG8_STAGE(PG8_SB(0, 0), cB, voffB); PG8_STAGE(PG8_SA(0, 0), cA, voffA); PG8_STAGE(PG8_SB(0, 1), cB + hstepB, voffB); PG8_STAGE(PG8_SA(0, 1), cA + hstep, voffA);
        if (wr == 1) PG8_BAR;
        PG8_WAIT_V(4); PG8_BAR;
        PG8_STAGE(PG8_SB(1, 0), cB + kstepB, voffB); PG8_STAGE(PG8_SA(1, 0), cA + kstep, voffA); PG8_STAGE(PG8_SB(1, 1), cB + hstepB + kstepB, voffB);
        PG8_WAIT_V(6); PG8_BAR;
    }
    for (;;) {
        const bool has_next = S.next(ui + 1, nxt);
        const char* nA = has_next ? (const char*)g.A + (size_t)nxt.pm * tstep : cA; const char* nB = has_next ? (const char*)g.Bt + (size_t)nxt.pn * tstepB : cB;
        for (int t = 0; t < nt; t += 2) {
            if constexpr (Epi::KSEG > 0) { if (t != 0 && (t % Epi::KSEG) == 0) E.kseg(acc, cur, t / Epi::KSEG, wr, wc, fr, fq); }
            const bool last = (t == nt - 2);
            const char* a1 = cA + (size_t)(t + 1) * kstep;
            const char* a2 = last ? nA : cA + (size_t)(t + 2) * kstep; const char* b2 = last ? nB : cB + (size_t)(t + 2) * kstepB;
            const char* a3 = a2 + kstep; const char* b3 = b2 + kstepB;
            if (last && has_next) S.a_ready(nxt);
            if constexpr (SP2) {
            PG8_LDB(B0, 0, 0); PG8_LDB(B1, 0, 1); PG8_SCHED; PG8_LDA(At, 0, 0); PG8_STAGE(PG8_SA(1, 1), a1 + hstep, voffA);
            PG8_WAIT_V(8); PG8_WAIT_L(0); PG8_BAR; PG8_MMA(0, 0, At, B0); PG8_MMA(0, 1, At, B1); PG8_BAR; PG8_SCHED;
            PG8_LDA(At, 0, 1); PG8_STAGE(PG8_SB(0, 0), b2, voffB); PG8_STAGE(PG8_SB(0, 1), b2 + hstepB, voffB); PG8_STAGE(PG8_SA(0, 0), a2, voffA);
            PG8_WAIT_V(8); PG8_WAIT_L(0); PG8_BAR; PG8_MMA(1, 0, At, B0); PG8_MMA(1, 1, At, B1); PG8_BAR; PG8_SCHED;
            PG8_LDB(B0, 1, 0); PG8_LDB(B1, 1, 1); PG8_SCHED; PG8_LDA(At, 1, 0); PG8_STAGE(PG8_SA(0, 1), a2 + hstep, voffA);
            PG8_WAIT_V(8); PG8_WAIT_L(0); PG8_BAR; PG8_MMA(0, 0, At, B0); PG8_MMA(0, 1, At, B1); PG8_BAR; PG8_SCHED;
            PG8_LDA(At, 1, 1); PG8_STAGE(PG8_SB(1, 0), b3, voffB); PG8_STAGE(PG8_SB(1, 1), b3 + hstepB, voffB); PG8_STAGE(PG8_SA(1, 0), a3, voffA);
            PG8_WAIT_V(8); PG8_WAIT_L(0); PG8_BAR; PG8_MMA(1, 0, At, B0); PG8_MMA(1, 1, At, B1); PG8_BAR; PG8_SCHED;
            } else {
            PG8_LDB(B0, 0, 0); PG8_SCHED; PG8_LDA(At, 0, 0); PG8_STAGE(PG8_SA(1, 1), a1 + hstep, voffA);
            PG8_WAIT_L(8); PG8_BAR; PG8_WAIT_L(0); PG8_MMA(0, 0, At, B0); PG8_BAR; PG8_SCHED;
            PG8_LDB(B1, 0, 1); PG8_STAGE(PG8_SB(0, 0), b2, voffB);
            PG8_BAR; PG8_WAIT_L(0); PG8_MMA(0, 1, At, B1); PG8_BAR;
            PG8_LDA(At, 0, 1); PG8_STAGE(PG8_SA(0, 0), a2, voffA);
            PG8_BAR; PG8_WAIT_L(0); PG8_MMA(1, 0, At, B0); PG8_BAR; PG8_SCHED;
            PG8_STAGE(PG8_SB(0, 1), b2 + hstepB, voffB);
            PG8_WAIT_V(6); PG8_BAR; PG8_MMA(1, 1, At, B1); PG8_BAR;
            PG8_LDB(B0, 1, 0); PG8_SCHED; PG8_LDA(At, 1, 0); PG8_STAGE(PG8_SA(0, 1), a2 + hstep, voffA);
            PG8_WAIT_L(8); PG8_BAR; PG8_WAIT_L(0); PG8_MMA(0, 0, At, B0); PG8_BAR; PG8_SCHED;
            PG8_LDB(B1, 1, 1); PG8_STAGE(PG8_SB(1, 0), b3, voffB);
            PG8_BAR; PG8_WAIT_L(0); PG8_MMA(0, 1, At, B1); PG8_BAR;
            PG8_LDA(At, 1, 1); PG8_STAGE(PG8_SA(1, 0), a3, voffA);
            PG8_BAR; PG8_WAIT_L(0); PG8_MMA(1, 0, At, B0); PG8_BAR; PG8_SCHED;
            PG8_STAGE(PG8_SB(1, 1), b3 + hstepB, voffB);
            PG8_WAIT_V(6); PG8_BAR; PG8_MMA(1, 1, At, B1); PG8_BAR;
            }
        }
        if constexpr (ALIGN_EPI) { if (wr == 0) PG8_BAR; }
        if constexpr (!Epi::AFTER_DRAIN) { E(acc, cur, wr, wc, fr, fq); if constexpr (Epi::EPI2) { asm volatile("" ::: "memory"); E(acc, cur, wr, wc, fr, fq); } S.done(cur); }
        if (!has_next) break;
#pragma unroll
        for (int a = 0; a < 2; ++a)
#pragma unroll
            for (int b = 0; b < 2; ++b)
#pragma unroll
                for (int m = 0; m < 4; ++m)
#pragma unroll
                    for (int n = 0; n < 2; ++n) acc[a][b][m][n] = (f32x4){0.f, 0.f, 0.f, 0.f};
        cur = nxt; cA = nA; cB = nB; ++ui;
        if constexpr (ALIGN_EPI) { if (wr == 1) PG8_BAR; }
    }
    PG8_WAIT_V(0);
    if constexpr (!ALIGN_EPI) { if (wr == 0) PG8_BAR; }
    PG8_BAR;
    if constexpr (Epi::AFTER_DRAIN) { E.fused(acc, cur, wr, wc, fr, fq, lds, wid, lane); S.done(cur); }
#undef PG8_SA
#undef PG8_SB
#undef PG8_STAGE
#undef PG8_LDA
#undef PG8_LDB
#undef PG8_MMA
#undef PG8_WAIT_V
#undef PG8_WAIT_L
#undef PG8_BAR
#undef PG8_SCHED
}
}


constexpr int NWAVES = 8, NTHREADS = 512;
constexpr int BATCH = 4, SEQ = 4096, DM = 2048, DEPTH = 4, M = BATCH * SEQ;
constexpr int IN_COLS = 13060, NIN = 13056, ZP = 4864, GP = 8192, DFF = 5632, NGU = 2 * DFF;
constexpr float RMS_EPS = 1e-6f, LOG2E = 1.4426950408889634f, NEGBIG = -1e30f;
constexpr int ZSP = 128;
__host__ __device__ __forceinline__ size_t zoff(int col, size_t row) { return ((size_t)(col >> 7) * (4 * 4096) + row) * 128 + (size_t)(col & 127); }
constexpr int ZC_AQ = 0, ZC_AK = 512, ZC_AV = 1024, ZC_BX = 1536, ZC_BG = 2048, ZC_CQ = 2560, ZC_CK = 3072, ZC_CV = 3584, ZC_DQ = 4096, ZC_DK = 4608, ZC_DV = 4736;

constexpr size_t MiB = 1u << 20;
constexpr size_t WS_CTL = 0, CTL_ZERO_BYTES = 2 * MiB;
constexpr size_t WS_GRAN = 1 * MiB;
constexpr size_t WS_KMAX = 512 * 1024;
constexpr size_t WS_WCF = 2 * MiB;
constexpr size_t WS_LRUK = 2 * MiB + 512 * 1024;
constexpr size_t WS_LOGF = 3 * MiB;
constexpr size_t WS_W = 4 * MiB, W_LAYER = 133 * MiB;
constexpr size_t WO_IN = 0, WO_BR = 51 * MiB, WO_OUT = 59 * MiB, WO_GU = 67 * MiB, WO_DN = 111 * MiB;
constexpr size_t WS_H = WS_W + DEPTH * W_LAYER;
constexpr size_t WS_U = WS_H + 128 * MiB;
constexpr size_t WS_Z = WS_U + 64 * MiB;
constexpr size_t WS_G = WS_Z + 152 * MiB;
constexpr size_t WS_Y = WS_G + 256 * MiB;
constexpr size_t WS_MIX = WS_Y + 64 * MiB;
constexpr size_t WS_OSCR = WS_MIX + 64 * MiB;
constexpr size_t WS_HL = WS_OSCR + 32 * MiB;
constexpr size_t WS_PL = WS_HL + 32 * MiB;
constexpr size_t WS_W8 = WS_PL + 32 * MiB;
constexpr size_t WS_U8 = WS_W8 + 4 * 16 * MiB;
constexpr size_t WS_END = WS_U8 + 32 * MiB;
constexpr float FP8_SA = 16.f, FP8_SW = 64.f;
static_assert((size_t)M * ZP * 2 <= 152 * MiB && (size_t)M * DFF * 2 <= 256 * MiB && (size_t)NIN * DM * 2 == 51 * MiB && (size_t)NGU * DM * 2 == 44 * MiB, "d_ws map");
constexpr int CW_BAR = 4096;
constexpr int CW_Q = 16384;

constexpr int RING_OFF = 0, RING_BYTES = 131072;
constexpr int LDSCTL_OFF = RING_BYTES, MISC_OFF = LDSCTL_OFF + 320;
constexpr int LDS_BYTES = 131072 + 1024 + 16384 + 1024;
constexpr int MX_KIMG = 0, MX_VIMG = 65536, MX_BIAS = LDSCTL_OFF + 1024, MX_SCR = MX_BIAS + 16384;
static_assert(MX_SCR + 1024 <= LDS_BYTES && MISC_OFF + 64 <= LDSCTL_OFF + 1024, "mixer LDS map");
constexpr int LR_P = 68;
constexpr int LR_XC = 0, LR_A = 34816, LR_U = 69632, LR_WT = 104448, LR_SEGA = 122880, LR_SEGH = 124928, LR_CARRY = 126976, LR_CARRYP = 127488, LR_HIN = 128000;
static_assert(LR_HIN + 256 <= RING_BYTES && LR_WT + 128 * 144 <= LR_SEGA, "LRU LDS map");

#define XB_LAS __attribute__((address_space(3)))


#define GAS __attribute__((address_space(1)))
#define LAS __attribute__((address_space(3)))
typedef unsigned short bf16;
typedef unsigned v4u __attribute__((ext_vector_type(4)));
typedef float f32x4 __attribute__((ext_vector_type(4)));
typedef short bf16x8 __attribute__((ext_vector_type(8)));
typedef GAS unsigned gu32;
typedef GAS unsigned long long gu64;
#define RLX_AGENT __ATOMIC_RELAXED, __HIP_MEMORY_SCOPE_AGENT
#define LDS_WAIT() asm volatile("s_waitcnt lgkmcnt(0)" ::: "memory")
#define VM_WAIT() asm volatile("s_waitcnt vmcnt(0)" ::: "memory")
__device__ __forceinline__ unsigned long long rt() { return __builtin_amdgcn_s_memrealtime(); }
__device__ __forceinline__ unsigned f2bf(float f) { unsigned u = __builtin_bit_cast(unsigned, f); return (u + 0x7fffu + ((u >> 16) & 1u)) >> 16; }
__device__ __forceinline__ unsigned pk2(float lo, float hi) { return f2bf(lo) | (f2bf(hi) << 16); }

#define XB_TMO      128
#define XB_XCNT(j)  (256  + 64 * (j))
#define XB_XSUB(j)  (1280 + 64 * (j))
#define XB_XGEN(j)  (2304 + 64 * (j))
#define XB_TOP      3328
#define XB_TOPGEN   3392
#define XCD_BAR_WORDS 3456
#define XB_SPIN_CAP (1u << 18)

__device__ __forceinline__ unsigned xb_ld(unsigned* p)              { return __hip_atomic_load(p, __ATOMIC_RELAXED, __HIP_MEMORY_SCOPE_AGENT); }
__device__ __forceinline__ unsigned xb_add(unsigned* p, unsigned v) { unsigned one; asm volatile("v_mov_b32 %0, 1" : "=v"(one)); (void)v; return __hip_atomic_fetch_add(p, one, __ATOMIC_RELAXED, __HIP_MEMORY_SCOPE_AGENT); }
__device__ __forceinline__ unsigned xb_xcc_id() { return (unsigned)__builtin_amdgcn_s_getreg((3 << 11) | 20) & 0xFu; }
#define XB_SPIN(cond, bar) do { unsigned _sp = 0; while (cond) { __builtin_amdgcn_s_sleep(1); \
    if ((++_sp & 255u) == 0u) { if (xb_ld(&(bar)[XB_TMO])) break; if (_sp > XB_SPIN_CAP) { (void)xb_add(&(bar)[XB_TMO], 1u); break; } } } } while (0)

struct XcdBarrier {
    bool lead; unsigned* bar; unsigned x;
    volatile LAS unsigned* st;
};

__device__ __forceinline__ XcdBarrier xcd_barrier_post(unsigned* bar, volatile LAS unsigned* st) {
    XcdBarrier b; b.bar = bar; b.x = xb_xcc_id(); b.st = st;
    if (threadIdx.x == 0) (void)xb_add(&bar[XB_XCNT(b.x)], 1u);
    return b;
}
__device__ __forceinline__ void xcd_barrier_complete(unsigned* bar, unsigned x, unsigned& nloc, unsigned& nx) {
    const unsigned G = gridDim.x * gridDim.y * gridDim.z;
    unsigned sum, cnt, mine, sp = 0u;
    for (;;) {
        sum = 0u; cnt = 0u; mine = 0u;
#pragma unroll
        for (unsigned j = 0; j < 16; ++j) { const unsigned c = xb_ld(&bar[XB_XCNT(j)]); sum += c; cnt += (c > 0u) ? 1u : 0u; mine = (j == x) ? c : mine; }
        if (sum == G) break;
        __builtin_amdgcn_s_sleep(1);
        if ((++sp & 255u) == 0u) { if (xb_ld(&bar[XB_TMO])) break; if (sp > XB_SPIN_CAP) { (void)xb_add(&bar[XB_TMO], 1u); break; } }
    }
    nloc = mine > 0u ? mine : 1u; nx = cnt > 0u ? cnt : 1u;
}

__device__ __forceinline__ void xcd_barrier(const XcdBarrier& b) {
    asm volatile("s_waitcnt vmcnt(0)" ::: "memory");
    __syncthreads();
    if (b.lead) {
        unsigned* bar = b.bar;
        __builtin_amdgcn_s_waitcnt(0);
        unsigned nloc = b.st[0], nx = b.st[1];
        if (nloc == 0u) { xcd_barrier_complete(bar, b.x, nloc, nx); b.st[0] = nloc; b.st[1] = nx; }
        const unsigned old = xb_add(&bar[XB_XSUB(b.x)], 1u);
        const unsigned gen = old / nloc;
        if (old + 1u == (gen + 1u) * nloc) {
            __builtin_amdgcn_fence(__ATOMIC_RELEASE, "agent");
            asm volatile("s_waitcnt vmcnt(0)" ::: "memory");
            const unsigned og = xb_add(&bar[XB_TOP], 1u);
            const unsigned tg = og / nx;
            if (og + 1u == (tg + 1u) * nx) xb_add(&bar[XB_TOPGEN], 1u);
            else XB_SPIN(xb_ld(&bar[XB_TOPGEN]) == tg, bar);
            __builtin_amdgcn_fence(__ATOMIC_ACQUIRE, "agent");
            xb_add(&bar[XB_XGEN(b.x)], 1u);
            asm volatile("s_waitcnt vmcnt(0)" ::: "memory");
        } else {
            XB_SPIN(xb_ld(&bar[XB_XGEN(b.x)]) == gen, bar);
            __builtin_amdgcn_fence(__ATOMIC_ACQUIRE, "agent");
            asm volatile("s_waitcnt vmcnt(0)" ::: "memory");
        }
    }
    __syncthreads();
}


typedef float f32x16 __attribute__((ext_vector_type(16)));
typedef short v4i16_t __attribute__((ext_vector_type(4)));
typedef float f32x2_t __attribute__((ext_vector_type(2)));
typedef __bf16 bf16x2_t __attribute__((ext_vector_type(2)));
typedef unsigned u32x2 __attribute__((ext_vector_type(2)));
__device__ __forceinline__ unsigned cvtpk(float lo, float hi) { f32x2_t v = {lo, hi}; bf16x2_t b = __builtin_convertvector(v, bf16x2_t); return __builtin_bit_cast(unsigned, b); }
__device__ __forceinline__ int mk_tid(int wv0) { unsigned ones = ~0u; asm volatile("" : "+s"(ones));
    return wv0 * 64 + (int)__builtin_amdgcn_mbcnt_hi(ones, __builtin_amdgcn_mbcnt_lo(ones, 0u)); }
__device__ __forceinline__ float opq(float x) { asm volatile("" : "+v"(x)); return x; }
__device__ __forceinline__ float bf2f(bf16 h) { return __builtin_bit_cast(float, (unsigned)h << 16); }
template <int MASK> __device__ __forceinline__ float xor_f(float v) { return __builtin_bit_cast(float, __builtin_amdgcn_ds_swizzle(__builtin_bit_cast(int, v), (MASK << 10) | 0x1f)); }
__device__ __forceinline__ void swap32(float v, float& lo, float& hi) { unsigned a = __builtin_bit_cast(unsigned, v), b = a; asm volatile("" : "+v"(b)); const auto r = __builtin_amdgcn_permlane32_swap(a, b, false, false);
    unsigned r0 = r[0], r1 = r[1]; asm volatile("" : "+v"(r0), "+v"(r1)); lo = __builtin_bit_cast(float, r0); hi = __builtin_bit_cast(float, r1); }
__device__ __forceinline__ float sum32(float v) { float a, b; swap32(v, a, b); return a + b; }
__device__ __forceinline__ float max32(float v) { float a, b; swap32(v, a, b); return fmaxf(a, b); }
__device__ __forceinline__ float wave_sum(float v) {
    v += xor_f<1>(v); v += xor_f<2>(v); v += xor_f<4>(v); v += xor_f<8>(v); v += xor_f<16>(v);
    return sum32(v);
}

struct Args { const float* in[25]; float* out; unsigned char* ws; int ph_lo, ph_hi; };
struct Frame {
    LAS unsigned char* lds;
    gu32* ctl;
    int tid, lane, wave, vcu, G, wv0;
    const Args* a;
    float* out;
    unsigned char* ws;
};
enum { I_X = 0, I_NORM_MIX, I_W_IN, I_B_GATE, I_LQ1, I_LK1, I_LQ2, I_LK2, I_SUBLN, I_CONV_W, I_CONV_B, I_WA, I_BA, I_WX, I_BX, I_LAMBDA, I_FOX_B, I_SINKS, I_W_BRANCH, I_W_OUT, I_NORM_FFN, I_W_GATE, I_W_UP, I_W_DOWN, I_NORM_FINAL };

struct CDesc { const float* src; unsigned char* dst; int ldsrc, scol4, lddst, drow0, dcol0, f8; };
constexpr int I_IN = 32 * 408, I_BR = 2048, I_OUT = 2048, I_G = 32 * 176, I_D = 88 * 64, PER_LAYER = I_IN + I_BR + I_OUT + 2 * I_G + I_D;
static_assert(I_IN % 128 == 0 && (PER_LAYER - I_IN) % 128 == 0, "weight blocks are dealt 128 at a time");
__device__ __forceinline__ CDesc conv_desc(Frame& F, int l, int r) {
    CDesc d; d.f8 = 0;
    unsigned char* wl = F.ws + WS_W + (size_t)l * W_LAYER;
    const int g4 = 4 * (F.lane & 7);
    if (r < I_IN) { const int kb = r / 408, nb = r % 408, n0 = 32 * nb;
        d.src = F.a->in[I_W_IN] + ((size_t)l * DM + 64 * kb) * IN_COLS; d.ldsrc = IN_COLS; d.lddst = DM; d.dcol0 = 64 * kb;
        if (n0 < 4864) { d.scol4 = (n0 < 4096 ? n0 : n0 + 4) + g4; d.dst = wl + WO_IN; d.drow0 = n0; }
        else { const int q = n0 - 4864, pnp = q >> 8, cl = (q & 255) + g4;
            d.scol4 = 4868 + (2 * (cl >> 7) + ((cl >> 2) & 1)) * 2048 + 64 * pnp + 16 * ((cl >> 5) & 3) + 4 * ((cl >> 3) & 3);
            d.dst = F.ws + WS_W8 + (size_t)l * (16 * MiB); d.drow0 = n0 - 4864; d.f8 = 1; }
        return d; }
    r -= I_IN;
    if (r < I_BR) { const int nbr = r / 512, q = r % 512, kb = q / 64, nb = q % 64;
        d.src = F.a->in[I_W_BRANCH] + (((size_t)l * 4 + nbr) * 512 + 64 * kb) * DM; d.ldsrc = DM; d.scol4 = 32 * nb + g4; d.dst = wl + WO_BR; d.lddst = DM; d.drow0 = 32 * nb; d.dcol0 = 512 * nbr + 64 * kb; return d; }
    r -= I_BR;
    if (r < I_OUT) { const int kb = r / 64, nb = r % 64;
        d.src = F.a->in[I_W_OUT] + ((size_t)l * DM + 64 * kb) * DM; d.ldsrc = DM; d.scol4 = 32 * nb + g4; d.dst = wl + WO_OUT; d.lddst = DM; d.drow0 = 32 * nb; d.dcol0 = 64 * kb; return d; }
    r -= I_OUT;
    if (r < 2 * I_G) { const int up = r / I_G, q = r % I_G, kb = q / 176, nb = q % 176, n0 = 32 * nb;
        d.src = F.a->in[up ? I_W_UP : I_W_GATE] + ((size_t)l * DM + 64 * kb) * DFF; d.ldsrc = DFF; d.scol4 = n0 + g4; d.dst = wl + WO_GU; d.lddst = DM; d.drow0 = (n0 >> 7) * 256 + (n0 & 127) + 128 * up; d.dcol0 = 64 * kb; return d; }
    r -= 2 * I_G;
    { const int kb = r / 64, nb = r % 64;
        d.src = F.a->in[I_W_DOWN] + ((size_t)l * DFF + 64 * kb) * DM; d.ldsrc = DM; d.scol4 = 32 * nb + g4; d.dst = wl + WO_DN; d.lddst = DFF; d.drow0 = 32 * nb; d.dcol0 = 64 * kb; }
    return d;
}
__device__ __forceinline__ size_t img_off(int n, int k, int nkt) {
    const int rr = n & 127, x = rr & 31, R = (rr & ~31) + 16 * ((x >> 2) & 1) + 4 * (x >> 3) + (x & 3);
    return ((((size_t)(n >> 8) * nkt + (k >> 6)) * 2 + ((n >> 7) & 1)) << 14) + (size_t)pg8::lds_byte(R, k & 63);
}
__device__ __forceinline__ void conv_load(const CDesc& d, f32x4 (&v)[8], int lane) {
#pragma unroll
    for (int i = 0; i < 8; ++i) v[i] = *(const f32x4*)(d.src + (size_t)(8 * i + (lane >> 3)) * d.ldsrc + d.scol4);
}
__device__ __forceinline__ void conv_store(const CDesc& d, const f32x4 (&v)[8], LAS float* scr, int lane) {
    const float sc = d.f8 ? FP8_SW : 1.f, lim = d.f8 ? 448.f : 3.0e38f;
#pragma unroll
    for (int i = 0; i < 8; ++i) { LAS float* p = scr + (8 * i + (lane >> 3)) * 33 + 4 * (lane & 7);
#pragma unroll
        for (int e = 0; e < 4; ++e) p[e] = fminf(fmaxf(v[i][e] * sc, -lim), lim); }
    LDS_WAIT(); asm volatile("" ::: "memory");
    const int c = lane & 7;
#pragma unroll
    for (int j = 0; j < 4; ++j) { const int n = (lane >> 3) + 8 * j; const LAS float* s = scr + (8 * c) * 33 + n;
        if (d.f8) {
            int lo = 0, hi = 0;
            lo = __builtin_amdgcn_cvt_pk_fp8_f32(s[0 * 33], s[1 * 33], lo, false); lo = __builtin_amdgcn_cvt_pk_fp8_f32(s[2 * 33], s[3 * 33], lo, true);
            hi = __builtin_amdgcn_cvt_pk_fp8_f32(s[4 * 33], s[5 * 33], hi, false); hi = __builtin_amdgcn_cvt_pk_fp8_f32(s[6 * 33], s[7 * 33], hi, true);
            u32x2 o; o.x = (unsigned)lo; o.y = (unsigned)hi;
            *(GAS u32x2*)(d.dst + img_off(d.drow0 + n, (d.dcol0 + 8 * c) >> 1, d.lddst >> 7)) = o;
        } else {
            v4u o; o.x = cvtpk(s[0 * 33], s[1 * 33]); o.y = cvtpk(s[2 * 33], s[3 * 33]); o.z = cvtpk(s[4 * 33], s[5 * 33]); o.w = cvtpk(s[6 * 33], s[7 * 33]);
            *(GAS v4u*)(d.dst + img_off(d.drow0 + n, d.dcol0 + 8 * c, d.lddst >> 6)) = o; } }
    LDS_WAIT(); asm volatile("" ::: "memory");
}
__device__ __forceinline__ void conv_run(Frame& F, int l, int r0, int step, int nblk, LAS float* scr) {
    f32x4 va[8], vb[8];
    { const CDesc d = conv_desc(F, l, r0); conv_load(d, va, F.lane); }
#pragma unroll 1
    for (int i = 0; i < nblk; i += 2) {
        if (i + 1 < nblk) { const CDesc d = conv_desc(F, l, r0 + (i + 1) * step); conv_load(d, vb, F.lane); }
        { int r = r0 + i * step; asm volatile("" : "+s"(r)); const CDesc d = conv_desc(F, l, r); conv_store(d, va, scr, F.lane); }
        if (i + 2 < nblk) { const CDesc d = conv_desc(F, l, r0 + (i + 2) * step); conv_load(d, va, F.lane); }
        if (i + 1 < nblk) { int r = r0 + (i + 1) * step; asm volatile("" : "+s"(r)); const CDesc d = conv_desc(F, l, r); conv_store(d, vb, scr, F.lane); }
    }
}
__device__ __forceinline__ void p0_weights(Frame& F) {
    LAS float* scr = (LAS float*)(F.lds + RING_OFF + F.wave * 16384);
    const int gw = F.vcu * NWAVES + F.wave, NGW = F.G * NWAVES;
    if (gw < I_IN) conv_run(F, 0, gw, NGW, (I_IN - gw + NGW - 1) / NGW, scr);
    for (int i = (F.vcu * NTHREADS + F.tid); i < DEPTH * 512; i += F.G * NTHREADS) { const float lm = F.a->in[I_LAMBDA][i]; ((float*)(F.ws + WS_LRUK))[i] = -8.0f * (fmaxf(-lm, 0.f) + log1pf(__expf(-fabsf(lm)))); }
    float* wcf = (float*)(F.ws + WS_WCF);
    for (int i = (F.vcu * NTHREADS + F.tid); i < DEPTH * DM; i += F.G * NTHREADS) { const int l = i / DM, k = i % DM;
        const float* w = F.a->in[I_W_IN] + ((size_t)l * DM + k) * IN_COLS + 4096;
        f32x4 o; o.x = w[0]; o.y = w[1]; o.z = w[2]; o.w = w[3]; *(f32x4*)(wcf + 4 * (size_t)i) = o; }
}

template <int MODE, bool SRC16> __device__ __forceinline__ void norm_phase(Frame& F, const void* srcv, const float* gain, bf16* U, float* outf, int layer) {
    LAS float* red = (LAS float*)(F.lds + RING_OFF);
    const int w = F.wave, fr = F.lane & 15, fq = F.lane >> 4;
    int par = 0;
    for (int rg = F.vcu; rg < M / 16; rg += F.G, par ^= 1) {
        const int m = 16 * rg + fr;
        f32x4 v[8][2]; float ss = 0.f;
#pragma unroll
        for (int i = 0; i < 8; ++i) { const int c0 = 64 * (4 * w + (i >> 1)) + 32 * (i & 1) + 8 * fq;
            if (SRC16) { const v4u q = *(const v4u*)((const char*)srcv + pg8::img_a(m, c0, 32));
                v[i][0] = (f32x4){__builtin_bit_cast(float, q.x << 16), __builtin_bit_cast(float, q.x & 0xffff0000u), __builtin_bit_cast(float, q.y << 16), __builtin_bit_cast(float, q.y & 0xffff0000u)};
                v[i][1] = (f32x4){__builtin_bit_cast(float, q.z << 16), __builtin_bit_cast(float, q.z & 0xffff0000u), __builtin_bit_cast(float, q.w << 16), __builtin_bit_cast(float, q.w & 0xffff0000u)};
            } else { const float* xr = (const float*)srcv + (size_t)m * DM + c0; v[i][0] = *(const f32x4*)xr; v[i][1] = *(const f32x4*)(xr + 4); } }
#pragma unroll
        for (int i = 0; i < 8; ++i)
#pragma unroll
            for (int h = 0; h < 2; ++h) ss += (v[i][h].x * v[i][h].x + v[i][h].y * v[i][h].y) + (v[i][h].z * v[i][h].z + v[i][h].w * v[i][h].w);
        ss += xor_f<16>(ss); ss = sum32(ss);
        if (fq == 0) red[(par * 8 + w) * 16 + fr] = ss;
        __syncthreads();
        float tot = 0.f;
#pragma unroll
        for (int ww = 0; ww < 8; ++ww) tot += red[(par * 8 + ww) * 16 + fr];
        const float rstd = rsqrtf(tot * (1.f / DM) + RMS_EPS);
        float c0_ = 0.f, c1_ = 0.f, c2_ = 0.f, c3_ = 0.f;
#pragma unroll
        for (int i = 0; i < 8; ++i) { const int c0 = 64 * (4 * w + (i >> 1)) + 32 * (i & 1) + 8 * fq;
            const f32x4 g0 = *(const f32x4*)(gain + c0), g1 = *(const f32x4*)(gain + c0 + 4);
            const f32x4 u0 = v[i][0] * rstd * g0, u1 = v[i][1] * rstd * g1;
            if (MODE == 2) { float* orow = outf + (size_t)m * DM + c0; *(f32x4*)orow = u0; *(f32x4*)(orow + 4) = u1; }
            else {
                v4u o; o.x = cvtpk(u0.x, u0.y); o.y = cvtpk(u0.z, u0.w); o.z = cvtpk(u1.x, u1.y); o.w = cvtpk(u1.z, u1.w);
                *(v4u*)((char*)U + pg8::img_a(m, c0, 32)) = o;
                if (MODE == 1) {
                    const f32x4 lo4 = {-448.f, -448.f, -448.f, -448.f}, hi4 = {448.f, 448.f, 448.f, 448.f};
                    const f32x4 q0 = __builtin_elementwise_min(__builtin_elementwise_max(u0 * FP8_SA, lo4), hi4), q1 = __builtin_elementwise_min(__builtin_elementwise_max(u1 * FP8_SA, lo4), hi4);
                    int wa = 0, wb = 0; wa = __builtin_amdgcn_cvt_pk_fp8_f32(q0.x, q0.y, wa, false); wa = __builtin_amdgcn_cvt_pk_fp8_f32(q0.z, q0.w, wa, true);
                    wb = __builtin_amdgcn_cvt_pk_fp8_f32(q1.x, q1.y, wb, false); wb = __builtin_amdgcn_cvt_pk_fp8_f32(q1.z, q1.w, wb, true);
                    u32x2 o8; o8.x = (unsigned)wa; o8.y = (unsigned)wb;
                    *(u32x2*)(F.ws + WS_U8 + pg8::img_a(m, c0 >> 1, 16)) = o8;
                    const float* wc = (const float*)(F.ws + WS_WCF) + ((size_t)layer * DM + c0) * 4;
#pragma unroll
                    for (int e = 0; e < 8; ++e) { const f32x4 wv_ = *(const f32x4*)(wc + 4 * e); const float u = (e < 4) ? u0[e & 3] : u1[e & 3];
                        c0_ += u * wv_.x; c1_ += u * wv_.y; c2_ += u * wv_.z; c3_ += u * wv_.w; }
                }
            }
        }
        if (MODE == 1) {
            c0_ += xor_f<16>(c0_); c0_ = sum32(c0_); c1_ += xor_f<16>(c1_); c1_ = sum32(c1_); c2_ += xor_f<16>(c2_); c2_ = sum32(c2_); c3_ += xor_f<16>(c3_); c3_ = sum32(c3_);
            LAS float* dots = red + 256 + (par * 8 + w) * 64;
            if (fq == 0) { f32x4 o = {c0_, c1_, c2_, c3_}; *(LAS f32x4*)(dots + 4 * fr) = o; }
            __syncthreads();
            if (w == 0 && fq == 0) { f32x4 acc = {0.f, 0.f, 0.f, 0.f};
#pragma unroll
                for (int ww = 0; ww < 8; ++ww) acc += *(const LAS f32x4*)(red + 256 + (par * 8 + ww) * 64 + 4 * fr);
                const float* fb = F.a->in[I_FOX_B] + 4 * layer; f32x4 o;
#pragma unroll
                for (int e = 0; e < 4; ++e) { const float x = acc[e] + fb[e]; o[e] = fminf(x, 0.f) - __logf(1.0f + __expf(-fabsf(x))); }
                *(f32x4*)((float*)(F.ws + WS_LOGF) + 4 * (size_t)m) = o; }
        }
    }
    __syncthreads();
}


__device__ __forceinline__ unsigned off_b(unsigned row, unsigned ch) { return 256u * row + 16u * (ch ^ (((row & 3u) << 2) | ((row >> 2) & 3u))); }
__device__ __forceinline__ v4i16_t tr_read(const LAS unsigned char* p) { return __builtin_amdgcn_ds_read_tr16_b64_v4i16((LAS v4i16_t*)p); }

#ifndef DBG_X
#define DBG_X 0
#endif
template <int NS, int NC, bool WINDOW>
__device__ __forceinline__ void attn_pass(LAS unsigned char* L, const bf16* __restrict__ Kg, const bf16* __restrict__ Vg, const bf16* __restrict__ Qlane, const int s0, const int c0,
                                          const int t_lo, const int t_hi, const int qpos, const int wq_min, const int wq_max, const int bias_k0, const float C2,
                                          f32x16 (&o)[NC], float& l_run, const int tid0) {
    int tid_ = tid0; asm volatile("" : "+v"(tid_));
    const int tid = tid_, lane = tid & 63, hi = lane >> 5, l31 = lane & 31;
    bf16x8 qf[NS];
#pragma unroll
    for (int s = 0; s < NS; ++s) qf[s] = *(const bf16x8*)(Qlane + 16 * s + 8 * hi);
#pragma unroll
    for (int c = 0; c < NC; ++c)
#pragma unroll
        for (int r = 0; r < 16; ++r) o[c][r] = 0.f;
    l_run = 0.f;
    const int wv = __builtin_amdgcn_readfirstlane(tid >> 6);
    const int srow = 4 * wv + (lane >> 4);
    const int sch = (lane & 15) ^ (((srow & 3) << 2) | ((srow >> 2) & 3));
    const bf16* kgp = Kg + (size_t)srow * ZSP + sch * 8;
    const bf16* vgp = Vg + (size_t)srow * ZSP + sch * 8;
#define MX_DMA(t_, buf_) do { const size_t g_ = (size_t)(t_) * 64 * ZSP; const int lb_ = (buf_) * 16384 + wv * 1024; \
        __builtin_amdgcn_global_load_lds((const unsigned*)(kgp + g_), (LAS unsigned*)(L + MX_KIMG + lb_), 16, 0, 0); \
        __builtin_amdgcn_global_load_lds((const unsigned*)(kgp + g_ + (size_t)32 * ZSP), (LAS unsigned*)(L + MX_KIMG + lb_ + 8192), 16, 0, 0); \
        __builtin_amdgcn_global_load_lds((const unsigned*)(vgp + g_), (LAS unsigned*)(L + MX_VIMG + lb_), 16, 0, 0); \
        __builtin_amdgcn_global_load_lds((const unsigned*)(vgp + g_ + (size_t)32 * ZSP), (LAS unsigned*)(L + MX_VIMG + lb_ + 8192), 16, 0, 0); } while (0)
    const unsigned xr = ((unsigned)(l31 & 3) << 2) | ((unsigned)(l31 >> 2) & 3u);
    const unsigned krow = 256u * (unsigned)l31;
    const unsigned blk = (lane >> 4) & 1, q4 = (lane & 15) >> 2, p = lane & 3;
    const unsigned trb0 = 256u * (4u * hi + q4) + 8u * (p & 1), trb1 = trb0 + 2048u;
    const unsigned xt0 = (q4 << 2) | ((unsigned)hi & 3u), xt1 = (q4 << 2) | (((unsigned)hi + 2u) & 3u);
    const unsigned cl = 2u * blk + (p >> 1);
    const int NT = t_hi - t_lo;
    MX_DMA(t_hi - 1, 0);
    if (NT > 1) MX_DMA(t_hi - 2, 1);
    asm volatile("s_waitcnt vmcnt(0) lgkmcnt(0)\n\ts_barrier" ::: "memory");
    const float sinit = -((const LAS float*)(L + MX_BIAS))[wq_max - bias_k0] / C2;
    for (int i = 0; i < NT; ++i) {
        const int t = t_hi - 1 - i, buf = i & 3;
        if (!(i & 1)) { if (i + 2 < NT) MX_DMA(t - 2, (i + 2) & 3); if (i + 3 < NT) MX_DMA(t - 3, (i + 3) & 3); }
        const int k0 = 64 * t;
        const bool skip = (k0 > wq_max) || (WINDOW && (k0 + 63 < wq_min - 127));
        if (!skip) {
            const LAS unsigned char* Kb = L + MX_KIMG + buf * 16384;
            const LAS unsigned char* Vb = L + MX_VIMG + buf * 16384;
            f32x16 sa[2];
            unsigned xr_ = xr, krow_ = krow; asm volatile("" : "+v"(xr_), "+v"(krow_));
            for (int xq = 0; xq < (DBG_X == 2 ? 2 : 1); ++xq) {
            if (xq) asm volatile("" : "+v"(sa[0]), "+v"(sa[1]));
#pragma unroll
            for (int r = 0; r < 16; ++r) { sa[0][r] = sinit; sa[1][r] = sinit; }
            constexpr int GS = (NS == 8) ? 2 : 4;
#pragma unroll
            for (int sg = 0; sg < NS; sg += GS) {
                bf16x8 kf[2][GS];
#pragma unroll
                for (int s = 0; s < GS; ++s) { const unsigned ch = (unsigned)(2 * (s0 + sg + s) + hi);
#pragma unroll
                    for (int b = 0; b < 2; ++b) kf[b][s] = *(const LAS bf16x8*)(Kb + b * 8192 + krow_ + 16u * (ch ^ xr_)); }
#pragma unroll
                for (int s = 0; s < GS; ++s)
#pragma unroll
                    for (int b = 0; b < 2; ++b) sa[b] = __builtin_amdgcn_mfma_f32_32x32x16_bf16(kf[b][s], qf[sg + s], sa[b], 0, 0, 0);
            }
            }
            const LAS float* bl = (const LAS float*)(L + MX_BIAS) + (k0 - bias_k0) + 4 * hi;
#pragma unroll
            for (int b = 0; b < 2; ++b)
#pragma unroll
                for (int rr = 0; rr < 4; ++rr) { const f32x4 bv = *(const LAS f32x4*)(bl + 32 * b + 8 * rr);
#pragma unroll
                    for (int e = 0; e < 4; ++e) sa[b][4 * rr + e] = __builtin_fmaf(sa[b][4 * rr + e], C2, bv[e]); }
            const bool need_mask = (k0 + 63 > wq_min) || (WINDOW && (k0 < wq_max - 127));
            if (need_mask) {
#pragma unroll
                for (int b = 0; b < 2; ++b)
#pragma unroll
                    for (int r = 0; r < 16; ++r) { const int kpos = k0 + 32 * b + (r & 3) + 8 * (r >> 2) + 4 * hi;
                        const bool bad = (kpos > qpos) || (WINDOW && (qpos - kpos >= 128));
                        sa[b][r] = bad ? NEGBIG : sa[b][r]; }
            }
            float mt = sa[0][0];
#pragma unroll
            for (int r = 1; r < 16; ++r) mt = fmaxf(mt, sa[0][r]);
#pragma unroll
            for (int r = 0; r < 16; ++r) mt = fmaxf(mt, sa[1][r]);
            if (__any(mt > 120.f)) {
#pragma unroll
                for (int b = 0; b < 2; ++b)
#pragma unroll
                    for (int r = 0; r < 16; ++r) sa[b][r] = fminf(sa[b][r], 120.f);
            }
            if (!__all(mt < -150.f)) {
            if (DBG_X == 3) { float du = 0.f;
#pragma unroll
                for (int b = 0; b < 2; ++b)
#pragma unroll
                    for (int r = 0; r < 16; ++r) du += __builtin_amdgcn_exp2f(sa[b][r] * 0.999f);
                asm volatile("" :: "v"(du)); }
            float ls = 0.f;
#pragma unroll
            for (int b = 0; b < 2; ++b)
#pragma unroll
                for (int r = 0; r < 16; ++r) { const float pv = __builtin_amdgcn_exp2f(sa[b][r]); sa[b][r] = pv; ls += pv; }
            l_run += ls;
            bf16x8 pf[4];
#pragma unroll
            for (int ks = 0; ks < 4; ++ks) { const int b = ks >> 1, r0 = 8 * (ks & 1);
                v4u w; w.x = cvtpk(sa[b][r0 + 0], sa[b][r0 + 1]); w.y = cvtpk(sa[b][r0 + 2], sa[b][r0 + 3]); w.z = cvtpk(sa[b][r0 + 4], sa[b][r0 + 5]); w.w = cvtpk(sa[b][r0 + 6], sa[b][r0 + 7]);
                pf[ks] = __builtin_bit_cast(bf16x8, w); }
            unsigned tb0_ = trb0, tb1_ = trb1, x0_ = xt0, x1_ = xt1, cl_ = cl; asm volatile("" : "+v"(tb0_), "+v"(tb1_), "+v"(x0_), "+v"(x1_), "+v"(cl_));
#pragma unroll
            for (int c = 0; c < NC; ++c) {
                const unsigned chb = 4u * (unsigned)(c0 + c) + cl_; const unsigned a0 = tb0_ + 16u * (chb ^ x0_), a1 = tb1_ + 16u * (chb ^ x1_);
                v4i16_t vlo[4], vhi[4];
#pragma unroll
                for (int ks = 0; ks < 4; ++ks) { vlo[ks] = tr_read(Vb + ks * 4096 + a0); vhi[ks] = tr_read(Vb + ks * 4096 + a1); }
#pragma unroll
                for (int ks = 0; ks < 4; ++ks) { const v4i16_t lo = vlo[ks], hv = vhi[ks];
                    const bf16x8 vf = (bf16x8){lo[0], lo[1], lo[2], lo[3], hv[0], hv[1], hv[2], hv[3]};
                    o[c] = __builtin_amdgcn_mfma_f32_32x32x16_bf16(vf, pf[ks], o[c], 0, 0, 0); }
            }
            }
        }
        if ((i & 1) || i + 1 == NT) asm volatile("s_waitcnt vmcnt(0) lgkmcnt(0)\n\ts_barrier" ::: "memory");
    }
#undef MX_DMA
}

template <int NC> __device__ __forceinline__ void store_o(bf16* Y, size_t grow, int colbase, int hi, const f32x16 (&o)[NC]) {
    const int ycol = colbase + 8 * (1 - hi);
#pragma unroll
    for (int c = 0; c < NC; ++c)
#pragma unroll
        for (int j = 0; j < 2; ++j) {
            const int ra = 8 * j, rb_ = 8 * j + 4;
            const auto r0 = __builtin_amdgcn_permlane32_swap(cvtpk(o[c][rb_ + 0], o[c][rb_ + 1]), cvtpk(o[c][ra + 0], o[c][ra + 1]), false, false);
            const auto r1 = __builtin_amdgcn_permlane32_swap(cvtpk(o[c][rb_ + 2], o[c][rb_ + 3]), cvtpk(o[c][ra + 2], o[c][ra + 3]), false, false);
            v4u v; v.x = r0[0]; v.y = r1[0]; v.z = r0[1]; v.w = r1[1];
            *(v4u*)((char*)Y + pg8::img_a((int)grow, ycol + 32 * c + 16 * j, 32)) = v; }
}


__device__ __forceinline__ float wave_max(float v) {
    v = max32(v); v = fmaxf(v, xor_f<16>(v)); v = fmaxf(v, xor_f<8>(v)); v = fmaxf(v, xor_f<4>(v)); v = fmaxf(v, xor_f<2>(v)); v = fmaxf(v, xor_f<1>(v));
    return v;
}
template <int NS>
__device__ __forceinline__ float q_norm2(const bf16* __restrict__ Qlane, int hi) {
    float ss = 0.f;
#pragma unroll
    for (int s = 0; s < NS; ++s) { const bf16x8 v = *(const bf16x8*)(Qlane + 16 * s + 8 * hi);
#pragma unroll
        for (int e = 0; e < 8; ++e) { const float f = bf2f((bf16)v[e]); ss += f * f; } }
    return sum32(ss);
}
template <int NM>
__device__ __forceinline__ int horizon(Frame& F, LAS unsigned char* L, const gu64* gran, int NTt, int ref_row, float C2, float qn2) {
    LAS float* scr = (LAS float*)(L + MX_SCR);
    const float wm = wave_max(qn2);
    if (F.lane == 0) scr[16 + F.wave] = wm;
    __syncthreads();
    if (F.wave == 0) {
        const LAS float* bias = (const LAS float*)(L + MX_BIAS);
        const int tt = F.lane;
        bool ok = tt < NTt;
        if (ok) {
            const float bd = bias[64 * tt + 63] - bias[ref_row];
#pragma unroll
            for (int m = 0; m < NM; ++m) {
                float q2 = 0.f;
#pragma unroll
                for (int w = 0; w < 8 / NM; ++w) q2 = fmaxf(q2, scr[16 + (8 / NM) * m + w]);
                unsigned long long g; unsigned spins = 0;
                for (;;) { g = __hip_atomic_load(gran + 64 * m + tt, RLX_AGENT); if ((g >> 32) == 1ull) break; __builtin_amdgcn_s_sleep(2); if (++spins > (1u << 16)) break; }
                const float kmax = __builtin_bit_cast(float, (unsigned)g);
                ok = ok && ((g >> 32) == 1ull) && (1.01f * C2 * __builtin_amdgcn_sqrtf(q2) * kmax + bd < -152.f);
            }
        }
        const unsigned long long mask = __ballot(ok);
        int ts = (~mask == 0ull) ? 64 : (int)__builtin_ctzll(~mask);
        if (ts > NTt - 1) ts = NTt - 1;
        if (F.lane == 0) ((LAS int*)scr)[32] = ts;
    }
    __syncthreads();
    return __builtin_amdgcn_readfirstlane(((LAS int*)scr)[32]);
}

__device__ __forceinline__ void unit_A(Frame& F, int layer, int b, int h, int qb) {
    LAS unsigned char* L = F.lds + RING_OFF;
    const bf16* Z = (const bf16*)(F.ws + WS_Z);
    const int hi = F.lane >> 5, l31 = F.lane & 31, q0 = 128 * qb, map = F.wave >> 2, wq_min = q0 + 32 * (F.wave & 3), qpos = wq_min + l31;
    const size_t rb = (size_t)b * SEQ;
    const float L2E = opq(LOG2E);
    const float slope2 = exp2f(-2.0f * (float)(h + 1)) * L2E;
    LAS float* bias = (LAS float*)(L + MX_BIAS);
    const int nkeys = q0 + 128;
    for (int i = F.tid; i < nkeys; i += NTHREADS) bias[i] = slope2 * (float)(i - (q0 + 127));
    const bf16* Kg = Z + zoff(ZC_AK + 128 * h, rb); const bf16* Vg = Z + zoff(ZC_AV + 128 * h, rb);
    const bf16* Ql = Z + zoff(ZC_AQ + 128 * h + 64 * map, rb + qpos);
    const float C2 = 0.125f * L2E;
    f32x16 o[4]; float l;
    int t_stop = 0;
    if (h < 2) t_stop = horizon<2>(F, L, (const gu64*)(F.ws + WS_KMAX) + (size_t)(((layer * 4 + b) * 12 + 2 * h) * 64), nkeys / 64, q0 + 31, C2, q_norm2<4>(Ql, hi));
    attn_pass<4, 4, false>(L, Kg, Vg, Ql, 4 * map, 0, t_stop, nkeys / 64, qpos, wq_min, wq_min + 31, 0, C2, o, l, F.tid);
    l = sum32(l);
    int t2 = mk_tid(F.wv0); asm volatile("" : "+v"(t2));
    const int lane2 = t2 & 63, wave2 = __builtin_amdgcn_readfirstlane(t2 >> 6), hi2 = lane2 >> 5, qpos2 = 128 * qb + 32 * (wave2 & 3) + (lane2 & 31);
    int ly = layer; asm volatile("" : "+s"(ly));
    const float lam_init = 0.8f - 0.6f * __expf(-0.3f * (float)ly);
    LAS f32x4* xch = (LAS f32x4*)(L + MX_KIMG) + (size_t)((wave2 & 3) * 16) * 64 + lane2;
    if (wave2 >= 4) {
        float lam;
        {   const float* lq1 = F.a->in[I_LQ1] + 64 * layer; const float* lk1 = F.a->in[I_LK1] + 64 * layer; const float* lq2 = F.a->in[I_LQ2] + 64 * layer; const float* lk2 = F.a->in[I_LK2] + 64 * layer;
            const float s1 = wave_sum(lq1[lane2] * lk1[lane2]), s2 = wave_sum(lq2[lane2] * lk2[lane2]);
            lam = __expf(s1) - __expf(s2) + lam_init; }
        const float sc = lam / l;
#pragma unroll
        for (int c = 0; c < 4; ++c)
#pragma unroll
            for (int rr = 0; rr < 4; ++rr) { f32x4 v; v.x = o[c][4 * rr] * sc; v.y = o[c][4 * rr + 1] * sc; v.z = o[c][4 * rr + 2] * sc; v.w = o[c][4 * rr + 3] * sc; xch[(4 * c + rr) * 64] = v; }
    }
    __syncthreads();
    if (wave2 < 4) {
        const float inv = 1.0f / l; float ss = 0.f;
#pragma unroll
        for (int c = 0; c < 4; ++c)
#pragma unroll
            for (int rr = 0; rr < 4; ++rr) { const f32x4 v = xch[(4 * c + rr) * 64];
#pragma unroll
                for (int e = 0; e < 4; ++e) { const float d = o[c][4 * rr + e] * inv - v[e]; o[c][4 * rr + e] = d; ss += d * d; } }
        ss = sum32(ss);
        const float rn = rsqrtf(ss * (1.f / 128.f) + RMS_EPS) * (1.f - lam_init);
        const float* sg = F.a->in[I_SUBLN] + 128 * layer + 4 * hi2;
#pragma unroll
        for (int c = 0; c < 4; ++c)
#pragma unroll
            for (int rr = 0; rr < 4; ++rr) { const f32x4 g = *(const f32x4*)(sg + 32 * c + 8 * rr);
#pragma unroll
                for (int e = 0; e < 4; ++e) o[c][4 * rr + e] *= rn * g[e]; }
        store_o<4>((bf16*)(F.ws + WS_Y), (size_t)b * SEQ + qpos2, 128 * h, hi2, o);
    }
    __syncthreads();
}

__device__ __forceinline__ void unit_C(Frame& F, int layer, int b, int h, int qb) {
    LAS unsigned char* L = F.lds + RING_OFF;
    const bf16* Z = (const bf16*)(F.ws + WS_Z); bf16* Y = (bf16*)(F.ws + WS_Y);
    const int hi = F.lane >> 5, l31 = F.lane & 31, q0 = 256 * qb, wq_min = q0 + 32 * F.wave, qpos = wq_min + l31;
    const size_t rb = (size_t)b * SEQ;
    LAS float* bias = (LAS float*)(L + MX_BIAS); LAS float* wtot = (LAS float*)(L + MX_SCR);
    const float L2E = opq(LOG2E);
    const int nkeys = q0 + 256;
    {
        const float* lf = (const float*)(F.ws + WS_LOGF) + rb * 4 + h;
        float v[8]; const int i0 = 8 * F.tid;
#pragma unroll
        for (int e = 0; e < 8; ++e) v[e] = (i0 + e < nkeys) ? lf[(size_t)(i0 + e) * 4] : 0.f;
#pragma unroll
        for (int e = 1; e < 8; ++e) v[e] += v[e - 1];
        float x = v[7];
#pragma unroll
        for (int o = 1; o < 64; o <<= 1) { const float t = __builtin_bit_cast(float, __builtin_amdgcn_ds_bpermute(4 * ((F.lane >= o) ? F.lane - o : F.lane), __builtin_bit_cast(int, x))); if (F.lane >= o) x += t; }
        if (F.lane == 63) wtot[F.wave] = x;
        __syncthreads();
        float woff = 0.f, tot = 0.f;
#pragma unroll
        for (int w = 0; w < NWAVES; ++w) { const float tw = wtot[w]; tot += tw; woff += (w < F.wave) ? tw : 0.f; }
        const float base = woff + (x - v[7]);
#pragma unroll
        for (int e = 0; e < 8; ++e) if (i0 + e < nkeys) bias[i0 + e] = (tot - (base + v[e])) * L2E;
    }
    const bf16* Kg = Z + zoff(ZC_CK + 128 * h, rb); const bf16* Vg = Z + zoff(ZC_CV + 128 * h, rb);
    const bf16* Ql = Z + zoff(ZC_CQ + 128 * h, rb + qpos);
    const float C2 = 0.08838834764831845f * L2E;
    f32x16 o[4]; float l;
    const int t_stop = horizon<1>(F, L, (const gu64*)(F.ws + WS_KMAX) + (size_t)(((layer * 4 + b) * 12 + 8 + h) * 64), nkeys / 64, q0 + 31, C2, q_norm2<8>(Ql, hi));
    attn_pass<8, 4, false>(L, Kg, Vg, Ql, 0, 0, t_stop, nkeys / 64, qpos, wq_min, wq_min + 31, 0, C2, o, l, F.tid);
    l = sum32(l);
    {   const float inv = 1.0f / l;
#pragma unroll
        for (int c = 0; c < 4; ++c)
#pragma unroll
            for (int r = 0; r < 16; ++r) o[c][r] *= inv; }
    store_o<4>(Y, rb + qpos, 1024 + 128 * h, hi, o);
}

__device__ __forceinline__ void unit_D(Frame& F, int layer, int b, int kv, int rbk) {
    LAS unsigned char* L = F.lds + RING_OFF;
    const bf16* Z = (const bf16*)(F.ws + WS_Z); bf16* Y = (bf16*)(F.ws + WS_Y);
    const int hi = F.lane >> 5, l31 = F.lane & 31, q0 = 64 * rbk, j = F.wave >> 1, hq = 4 * kv + j, wq_min = q0 + 32 * (F.wave & 1), qpos = wq_min + l31;
    const size_t rb = (size_t)b * SEQ;
    const float L2E = opq(LOG2E);
    LAS float* bias = (LAS float*)(L + MX_BIAS);
    const int k_lo = (q0 >= 128) ? q0 - 128 : 0, nkeys = q0 + 64 - k_lo;
    for (int i = F.tid; i < 1024; i += NTHREADS) { const int jj = i >> 8, ii = i & 255;
        if (ii < nkeys) bias[i] = exp2f(-(float)(4 * kv + jj + 1)) * L2E * (float)(k_lo + ii - (q0 + 63)); }
    const float slope2 = exp2f(-(float)(hq + 1)) * L2E;
    const bf16* Kg = Z + zoff(ZC_DK, rb); const bf16* Vg = Z + zoff(ZC_DV, rb);
    const bf16* Ql = Z + zoff(ZC_DQ + 64 * hq, rb + qpos);
    const float C2 = 0.125f * L2E;
    f32x16 o[2]; float l;
    attn_pass<4, 2, true>(L, Kg, Vg, Ql, 4 * kv, 2 * kv, k_lo / 64, (q0 + 64) / 64, qpos, wq_min, wq_min + 31, k_lo - 256 * j, C2, o, l, F.tid);
    l = sum32(l);
    {   const float sink2 = F.a->in[I_SINKS][8 * layer + hq] * L2E;
        const float inv = 1.0f / (l + __builtin_amdgcn_exp2f(sink2 + slope2 * (float)(qpos - (wq_min + 31))));
#pragma unroll
        for (int c = 0; c < 2; ++c)
#pragma unroll
            for (int r = 0; r < 16; ++r) o[c][r] *= inv; }
    store_o<2>(Y, rb + qpos, 1536 + 64 * hq, hi, o);
}

__device__ __forceinline__ void unit_N(Frame& F, int layer, int b, int hm) {
    const bf16* Z = (const bf16*)(F.ws + WS_Z);
    const int col = (hm < 8) ? ZC_AK + 64 * hm : ZC_CK + 128 * (hm - 8);
    const int nh = (hm < 8) ? 1 : 2;
    gu64* gran = (gu64*)(F.ws + WS_KMAX) + (size_t)(((layer * 4 + b) * 12 + hm) * 64);
    unsigned tag1; asm volatile("v_mov_b32 %0, 1" : "=v"(tag1));
#pragma unroll 1
    for (int i = 0; i < 8; ++i) {
        const int tile = 8 * i + F.wave;
        const bf16* kp = Z + zoff(col, (size_t)b * SEQ + 64 * tile + F.lane);
        float ss = 0.f;
#pragma unroll 1
        for (int hf = 0; hf < nh; ++hf) {
            bf16x8 v[8];
#pragma unroll
            for (int c = 0; c < 8; ++c) v[c] = *(const bf16x8*)(kp + 64 * hf + 8 * c);
#pragma unroll
            for (int c = 0; c < 8; ++c)
#pragma unroll
                for (int e = 0; e < 8; ++e) { const float f = bf2f((bf16)v[c][e]); ss += f * f; }
        }
        const float m = __builtin_amdgcn_sqrtf(wave_max(ss));
        if (F.lane == 0) __hip_atomic_store(gran + tile, ((unsigned long long)tag1 << 32) | (unsigned long long)__builtin_bit_cast(unsigned, m), RLX_AGENT);
    }
}

constexpr int MXW_A = (PER_LAYER - I_IN) / 128, MXW_B = I_IN / 128;
__device__ __forceinline__ void unit_W(Frame& F, int layer, int j) {
    LAS float* scr = (LAS float*)(F.lds + RING_OFF + F.wave * 16384);
    int l = layer, r0 = I_IN + 128 * j;
    if (j >= MXW_A) { l = layer + 1; r0 = 128 * (j - MXW_A); if (l >= DEPTH || j >= MXW_A + MXW_B) return; }
    conv_run(F, l, r0 + F.wave, 8, 16, scr);
}


__device__ __forceinline__ float neg_expm1(float x) {
    const float p = x * (1.f + x * (0.5f + x * (0.16666667f + x * (0.041666668f + x * (0.008333334f + x * (0.0013888889f + x * (0.0001984127f + x * 0.0000248016f)))))));
    return (x > -0.35f) ? -p : (1.f - __expf(x));
}
__device__ __forceinline__ float gelu_tanh(float x) { const float u = 0.7978845608028654f * (x + 0.044715f * x * x * x); const float t = 1.f - 2.f * __builtin_amdgcn_rcpf(1.f + __expf(2.f * u)); return 0.5f * x * (1.f + t); }
__device__ __forceinline__ void unit_B(Frame& F, int layer, int b, int n, int c) {
    LAS unsigned char* L = F.lds + RING_OFF;
    const bf16* Z = (const bf16*)(F.ws + WS_Z); bf16* Y = (bf16*)(F.ws + WS_Y);
    LAS float* XC = (LAS float*)(L + LR_XC); LAS float* AA = (LAS float*)(L + LR_A); LAS float* UU = (LAS float*)(L + LR_U);
    LAS bf16* WT = (LAS bf16*)(L + LR_WT); LAS float* SEGA = (LAS float*)(L + LR_SEGA); LAS float* SEGH = (LAS float*)(L + LR_SEGH);
    LAS float* CARRY = (LAS float*)(L + LR_CARRY); LAS float* CARRYP = (LAS float*)(L + LR_CARRYP); LAS float* HIN = (LAS float*)(L + LR_HIN);
    const int tid = F.tid, lane = F.lane, wave = F.wave, hi = lane >> 5, l31 = lane & 31;
    const size_t rb = (size_t)b * SEQ;
    const int ch0 = 64 * n;
    {   const float* wa = F.a->in[I_WA] + ((size_t)layer * 8 + n) * 4096; const float* wx = F.a->in[I_WX] + ((size_t)layer * 8 + n) * 4096;
        for (int i = tid; i < 8192; i += NTHREADS) { const int which = i >> 12, q = i & 4095, cc = q >> 6, d = q & 63;
            const float v = which ? wx[q] : wa[q]; WT[(64 * which + d) * 72 + cc] = (bf16)(cvtpk(v, 0.f) & 0xffffu); } }
    if (tid < 64) { CARRY[tid] = 0.f; CARRYP[tid] = 1.f; }
    const int sc = tid & 63, seg = tid >> 6;
    float cw[4];
#pragma unroll
    for (int j = 0; j < 4; ++j) cw[j] = F.a->in[I_CONV_W][((size_t)layer * 4 + j) * 512 + ch0 + sc];
    const float cb = F.a->in[I_CONV_B][layer * 512 + ch0 + sc];
    const int tb = wave >> 1, chh = wave & 1;
    float k_ba[16], k_bx[16], k_sp[16];
#pragma unroll
    for (int r = 0; r < 16; ++r) { const int cc = ch0 + 32 * chh + (r & 3) + 8 * (r >> 2) + 4 * hi;
        k_ba[r] = F.a->in[I_BA][layer * 512 + cc]; k_bx[r] = F.a->in[I_BX][layer * 512 + cc];
        k_sp[r] = ((const float*)(F.ws + WS_LRUK))[layer * 512 + cc]; }
    __syncthreads();
    const bf16* bxp = Z + zoff(ZC_BX + ch0 + sc, rb);
    f32x2_t* hpp = (f32x2_t*)(F.ws + WS_HL) + rb * 512 + ch0 + sc;
    unsigned short xr[19];
#pragma unroll
    for (int j = 0; j < 19; ++j) { const int t = 512 * c + 16 * seg - 3 + j; xr[j] = (t >= 0) ? bxp[(size_t)t * ZSP] : (unsigned short)0; }
#pragma unroll
    for (int j = 0; j < 16; ++j) XC[(16 * seg + j) * LR_P + sc] = cb + cw[0] * bf2f(xr[j]) + cw[1] * bf2f(xr[j + 1]) + cw[2] * bf2f(xr[j + 2]) + cw[3] * bf2f(xr[j + 3]);
    for (int tile = 0; tile < 4; ++tile) {
        const int t0 = 512 * c + 128 * tile;
        if (tile < 3) {
#pragma unroll
            for (int j = 0; j < 19; ++j) xr[j] = bxp[(size_t)(t0 + 128 + 16 * seg - 3 + j) * ZSP]; }
        __syncthreads();
        {   f32x16 dr, di;
#pragma unroll
            for (int r = 0; r < 16; ++r) { dr[r] = 0.f; di[r] = 0.f; }
            const LAS float* xrow = XC + (32 * tb + l31) * LR_P + 8 * hi;
#pragma unroll
            for (int s = 0; s < 4; ++s) {
                const f32x4 x0 = *(const LAS f32x4*)(xrow + 16 * s), x1 = *(const LAS f32x4*)(xrow + 16 * s + 4);
                v4u xw; xw.x = cvtpk(x0.x, x0.y); xw.y = cvtpk(x0.z, x0.w); xw.z = cvtpk(x1.x, x1.y); xw.w = cvtpk(x1.z, x1.w);
                const bf16x8 xf = __builtin_bit_cast(bf16x8, xw);
                const bf16x8 wr_ = *(const LAS bf16x8*)(WT + (32 * chh + l31) * 72 + 16 * s + 8 * hi);
                const bf16x8 wi_ = *(const LAS bf16x8*)(WT + (64 + 32 * chh + l31) * 72 + 16 * s + 8 * hi);
                dr = __builtin_amdgcn_mfma_f32_32x32x16_bf16(wr_, xf, dr, 0, 0, 0);
                di = __builtin_amdgcn_mfma_f32_32x32x16_bf16(wi_, xf, di, 0, 0, 0);
            }
            const int trow = 32 * tb + l31;
#pragma unroll
            for (int rr = 0; rr < 4; ++rr) { const int cc = 32 * chh + 8 * rr + 4 * hi;
                const f32x4 xc4 = *(const LAS f32x4*)(XC + trow * LR_P + cc);
                f32x4 a4, u4;
#pragma unroll
                for (int e = 0; e < 4; ++e) { const int r = 4 * rr + e;
                    const float rg = __builtin_amdgcn_rcpf(1.f + __expf(-(dr[r] + k_ba[r]))), ig = __builtin_amdgcn_rcpf(1.f + __expf(-(di[r] + k_bx[r])));
                    const float la = rg * k_sp[r];
                    a4[e] = __expf(la); u4[e] = __builtin_amdgcn_sqrtf(neg_expm1(2.f * la)) * (ig * xc4[e]); }
                *(LAS f32x4*)(AA + trow * LR_P + cc) = a4; *(LAS f32x4*)(UU + trow * LR_P + cc) = u4; }
        }
        __syncthreads();
        float av[16], uv[16];
        {   float hl = 0.f, ap = 1.f;
#pragma unroll
            for (int j = 0; j < 16; ++j) { av[j] = AA[(16 * seg + j) * LR_P + sc]; uv[j] = UU[(16 * seg + j) * LR_P + sc]; hl = av[j] * hl + uv[j]; ap *= av[j]; }
            SEGA[seg * 64 + sc] = ap; SEGH[seg * 64 + sc] = hl; }
        if (tile < 3) {
#pragma unroll
            for (int j = 0; j < 16; ++j) XC[(16 * seg + j) * LR_P + sc] = cb + cw[0] * bf2f(xr[j]) + cw[1] * bf2f(xr[j + 1]) + cw[2] * bf2f(xr[j + 2]) + cw[3] * bf2f(xr[j + 3]); }
        __syncthreads();
        {   float h = CARRY[(tile & 1) * 64 + sc], p = CARRYP[(tile & 1) * 64 + sc];
            for (int s = 0; s < seg; ++s) { const float sa_ = SEGA[s * 64 + sc]; h = sa_ * h + SEGH[s * 64 + sc]; p *= sa_; }
#pragma unroll
            for (int j = 0; j < 16; ++j) { h = av[j] * h + uv[j]; p *= av[j];
                f32x2_t hp_; hp_.x = h; hp_.y = p; hpp[(size_t)(t0 + 16 * seg + j) * 512] = hp_; }
            if (seg == 7) { CARRY[((tile + 1) & 1) * 64 + sc] = h; CARRYP[((tile + 1) & 1) * 64 + sc] = p; } }
    }
    asm volatile("s_waitcnt vmcnt(0)" ::: "memory");
    __syncthreads();
    if (wave == 0) {
        gu64* gran = (gu64*)(F.ws + WS_GRAN) + ((size_t)((layer * 32 + b * 8 + n) * 8) * 128);
        const float he = CARRY[lane], pe = CARRYP[lane];
        unsigned tag1; asm volatile("v_mov_b32 %0, 1" : "=v"(tag1));
        __hip_atomic_store(gran + (size_t)c * 128 + 2 * lane, ((unsigned long long)tag1 << 32) | (unsigned long long)__builtin_bit_cast(unsigned, he), RLX_AGENT);
        __hip_atomic_store(gran + (size_t)c * 128 + 2 * lane + 1, ((unsigned long long)tag1 << 32) | (unsigned long long)__builtin_bit_cast(unsigned, pe), RLX_AGENT);
        float hin = 0.f;
#pragma unroll 1
        for (int cb4 = 0; cb4 < c; cb4 += 4) {
            unsigned long long gh[4], gp[4]; unsigned spins = 0;
            for (;;) { bool ok = true;
#pragma unroll
                for (int q = 0; q < 4; ++q) if (cb4 + q < c) { gh[q] = __hip_atomic_load(gran + (size_t)(cb4 + q) * 128 + 2 * lane, RLX_AGENT); gp[q] = __hip_atomic_load(gran + (size_t)(cb4 + q) * 128 + 2 * lane + 1, RLX_AGENT); }
#pragma unroll
                for (int q = 0; q < 4; ++q) if (cb4 + q < c) ok = ok && ((gh[q] >> 32) == 1ull) && ((gp[q] >> 32) == 1ull);
                if (__all(ok)) break;
                __builtin_amdgcn_s_sleep(2); if (++spins > (1u << 22)) break; }
#pragma unroll
            for (int q = 0; q < 4; ++q) if (cb4 + q < c) hin = __builtin_bit_cast(float, (unsigned)gp[q]) * hin + __builtin_bit_cast(float, (unsigned)gh[q]);
        }
        HIN[lane] = hin;
    }
    __syncthreads();
    {   const float hin = HIN[sc];
        const bf16* bgp = Z + zoff(ZC_BG + ch0 + sc, rb + 512 * c + 64 * seg);
        const f32x2_t* hp2 = hpp + (size_t)(512 * c + 64 * seg) * 512;
        const int yrow = (int)rb + 512 * c + 64 * seg, ycol = 512 + ch0 + sc;
        f32x2_t hpv[2][16]; unsigned short gv[2][16];
#pragma unroll
        for (int j = 0; j < 16; ++j) { hpv[0][j] = hp2[(size_t)j * 512]; gv[0][j] = bgp[(size_t)j * ZSP]; }
#pragma unroll
        for (int jb = 0; jb < 4; ++jb) {
            const int j0 = 16 * jb;
            if (jb < 3) {
#pragma unroll
                for (int j = 0; j < 16; ++j) { hpv[(jb + 1) & 1][j] = hp2[(size_t)(j0 + 16 + j) * 512]; gv[(jb + 1) & 1][j] = bgp[(size_t)(j0 + 16 + j) * ZSP]; } }
#pragma unroll
            for (int j = 0; j < 16; ++j) *(bf16*)((char*)Y + pg8::img_a(yrow + j0 + j, ycol, 32)) = (bf16)(cvtpk(gelu_tanh(bf2f(gv[jb & 1][j])) * (hpv[jb & 1][j].x + hpv[jb & 1][j].y * hin), 0.f) & 0xffffu);
        }
    }
    __syncthreads();
}

#ifndef DBG_A2
#define DBG_A2 1
#endif
#ifndef DBG_C2
#define DBG_C2 1
#endif
#ifndef DBG_D2
#define DBG_D2 1
#endif
#ifndef DBG_DUP
#define DBG_DUP 0
#endif
constexpr int MXN_B = 256, MXN_GW = 27, MXN_WG = 10, MXN_AC = 16 * 48 + MXN_WG * MXN_GW, MXN_D = 512, MXN_EARLY = 128, MXN_N = 48, MX_ITEMS = MXN_EARLY + MXN_N + MXN_B + MXN_AC + MXN_D;
static_assert(MXN_WG * MXN_GW >= MXW_A + MXW_B, "weight items");
__device__ __forceinline__ void mixer_phase(Frame& F, int lq) {
    const int layer = lq & 3;
    LAS unsigned* itemw = (LAS unsigned*)(F.lds + LDSCTL_OFF);
    for (;;) {
        __syncthreads();
        if (F.tid == 0) *itemw = __hip_atomic_fetch_add((unsigned*)(F.ctl + CW_Q + 64 * lq), 1u, __ATOMIC_RELAXED, __HIP_MEMORY_SCOPE_AGENT);
        __syncthreads();
        const int it = __builtin_amdgcn_readfirstlane((int)*itemw);
        if (it >= MX_ITEMS) break;
        { int t_ = mk_tid(F.wv0); asm volatile("" : "+v"(t_)); F.tid = t_; F.lane = t_ & 63; F.wave = __builtin_amdgcn_readfirstlane(t_ >> 6); }
        int kind, ua, ub, uc;
        if (it < MXN_EARLY) { kind = 0; ua = (it & 7) >> 1; ub = 2 + (it & 1); uc = 31 - (it >> 3); }
        else if (it < MXN_EARLY + MXN_N) { const int r = it - MXN_EARLY; kind = 5; ua = r / 12; ub = r % 12; uc = 0; }
        else if (it < MXN_EARLY + MXN_N + MXN_B) { const int ib = it - MXN_EARLY - MXN_N; kind = 1; ua = (ib & 31) >> 3; ub = ib & 7; uc = ib >> 5; }
        else if (it < MXN_EARLY + MXN_N + MXN_B + MXN_AC) { const int r = it - MXN_EARLY - MXN_N - MXN_B, gw_ = (r < MXN_WG * (48 + MXN_GW)), r2 = gw_ ? r : r - MXN_WG * (48 + MXN_GW), g = gw_ ? r2 / (48 + MXN_GW) : MXN_WG + r2 / 48, w = gw_ ? r2 % (48 + MXN_GW) : r2 % 48;
            if (w < 32) { const int qb = 2 * (15 - g) + 1 - (w >> 4), ww = w & 15; kind = ((ww & 3) >= 2 && qb >= 16) ? 4 : 0; ua = ww >> 2; ub = ww & 3; uc = qb; }
            else if (w < 48) { kind = 2; ua = (w - 32) >> 2; ub = (w - 32) & 3; uc = 15 - g; }
            else { kind = 6; ua = MXN_GW * g + (w - 48); ub = 0; uc = 0; } }
        else { const int r = it - MXN_EARLY - MXN_N - MXN_B - MXN_AC; kind = 3; ua = (r & 7) >> 1; ub = r & 1; uc = 63 - (r >> 3); }
        if (kind == 0) {
#ifndef NO_A
#ifdef DBG_REPK
            for (int rr_ = 0; rr_ < ((DBG_REPK == 0 || (DBG_REPK == 6 && ub >= 2) || (DBG_REPK == 7 && ub < 2)) ? 2 : 1); ++rr_)
#endif
            unit_A(F, layer, ua, ub, uc);
#endif
        } else if (kind == 1) {
#ifndef NO_B
#ifdef DBG_REPK
            for (int rr_ = 0; rr_ < ((DBG_REPK == 1) ? 2 : 1); ++rr_)
#endif
            unit_B(F, layer, ua, ub, uc);
#endif
        } else if (kind == 2) {
#ifndef NO_C
#ifdef DBG_REPK
            for (int rr_ = 0; rr_ < ((DBG_REPK == 2) ? 2 : 1); ++rr_)
#endif
            unit_C(F, layer, ua, ub, uc);
#endif
        } else if (kind == 3) {
#ifndef NO_D
#ifdef DBG_REPK
            for (int rr_ = 0; rr_ < ((DBG_REPK == 3) ? 2 : 1); ++rr_)
#endif
            unit_D(F, layer, ua, ub, uc);
#endif
        } else if (kind == 5) {
            unit_N(F, layer, ua, ub);
        } else if (kind == 6) {
            unit_W(F, layer, ua);
        }
    }
}


#ifndef MK_SPLIT
#define MK_SPLIT 0
#endif
constexpr int NPHASES = 2 + 8 * DEPTH;
__global__ void __launch_bounds__(NTHREADS, 2) mk_fwd(Args args) {
    extern __shared__ __attribute__((aligned(16))) unsigned char lds[];
    Frame F;
    F.lds = (LAS unsigned char*)lds;
    F.tid = threadIdx.x; F.lane = F.tid & 63; F.wave = __builtin_amdgcn_readfirstlane(F.tid >> 6); F.wv0 = F.wave;
    F.G = gridDim.x; { const int bx = blockIdx.x; F.vcu = (F.G % 8 == 0) ? (bx % 8) * (F.G / 8) + bx / 8 : bx; }
    F.ws = args.ws; F.ctl = (gu32*)(args.ws + WS_CTL); F.out = args.out;
    F.a = &args;
    for (int u = F.tid; u < (LDS_BYTES - LDSCTL_OFF) / 4; u += NTHREADS) ((LAS unsigned*)(F.lds + LDSCTL_OFF))[u] = 0u;
    __syncthreads();
    volatile LAS unsigned* MISC = (volatile LAS unsigned*)(F.lds + MISC_OFF);
    XcdBarrier bar; bar.lead = false; bar.bar = (unsigned*)(F.ctl + CW_BAR); bar.x = 0; bar.st = nullptr;
    if (!MK_SPLIT) bar = xcd_barrier_post((unsigned*)(F.ctl + CW_BAR), MISC + 8);
    const int lo = args.ph_lo, hi = args.ph_hi;
#ifndef ONLY
#define ONLY -1
#endif
#define ON(j) (ONLY < 0 || ONLY == (j))
#ifndef REPEAT_MASK
#define REPEAT_MASK 0
#endif
#define REPS(j) (((REPEAT_MASK >> (j)) & 1) ? 2 : 1)
#define IN(k) (lo <= (k) && (k) < hi)
#ifndef DBG_SLEEP
#define DBG_SLEEP 0
#endif
#ifndef DBG_BAR2
#define DBG_BAR2 1
#endif
#define SEAM(k) do { if (IN(k) && IN((k) + 1)) { for (int br_ = 0; br_ < DBG_BAR2; ++br_) { XcdBarrier b_ = bar; asm volatile("" : "+s"(b_.bar), "+s"(b_.x)); b_.lead = (mk_tid(F.wv0) == 0); xcd_barrier(b_); } if (DBG_SLEEP) { for (int sl_ = 0; sl_ < DBG_SLEEP; ++sl_) __builtin_amdgcn_s_sleep(127); } } } while (0)

#define OPQ_WS() unsigned char* ws_ = F.ws; asm volatile("" : "+s"(ws_))
#define H ((bf16*)(ws_ + WS_H))
#define U ((bf16*)(ws_ + WS_U))
#define Zb ((bf16*)(ws_ + WS_Z))
#define Gb ((bf16*)(ws_ + WS_G))
#define Yb ((bf16*)(ws_ + WS_Y))
#define MIXb ((bf16*)(ws_ + WS_MIX))
#define HID ((bf16*)(ws_ + WS_G))

    for (int rep = 0; rep < REPS(8); ++rep) { if constexpr (ON(10)) if (IN(0)) { p0_weights(F); } SEAM(0); }
    if constexpr (ON(11)) if (IN(1)) { OPQ_WS(); norm_phase<1, false>(F, F.a->in[I_X], F.a->in[I_NORM_MIX], U, nullptr, 0); } SEAM(1);

#ifdef UNROLL_LAYERS
#pragma unroll
#endif
    for (int layer = 0; layer < DEPTH; ++layer) {
        const int pb = 2 + 8 * layer;
#define REFRESH() do { int t_ = mk_tid(F.wv0); asm volatile("" : "+v"(t_)); F.tid = t_; F.lane = t_ & 63; F.wave = __builtin_amdgcn_readfirstlane(t_ >> 6); } while (0)
        for (int rep = 0; rep < REPS(0); ++rep) {
        if constexpr (ON(0)) if (IN(pb + 0)) {
            OPQ_WS(); unsigned char* wl = ws_ + WS_W + (size_t)layer * W_LAYER;
#ifndef NO_ZG
            {   pg8::Gemm g{U, (const bf16*)(wl + WO_IN), M, ZP, DM}; pg8::StaticOrder S; S.init(M, ZP, F.G, (int)blockIdx.x);
                pg8::EpiZ E{Zb};
                pg8::gemm_phase<pg8::EpiZ, pg8::StaticOrder, true, true, false, true>(F.lds + RING_OFF, g, S, E, F.wv0); }
#endif
#ifndef NO_G8
            {   pg8::Gemm g{(const bf16*)(ws_ + WS_U8), (const bf16*)(ws_ + WS_W8 + (size_t)layer * (16 * MiB)), M, GP, DM / 2}; pg8::StaticOrder S; S.init(M, GP, F.G, (int)blockIdx.x);
                pg8::EpiG E{Gb, F.a->in[I_B_GATE] + (size_t)layer * GP, 1.f / (FP8_SA * FP8_SW)};
                pg8::gemm_phase<pg8::EpiG, pg8::StaticOrder, true, true, true, true>(F.lds + RING_OFF, g, S, E, F.wv0); }
#endif
        }
        SEAM(pb + 0); }
#ifndef NO_MIX
        for (int rep = 0; rep < REPS(1); ++rep) { if constexpr (ON(1)) if (IN(pb + 1)) { REFRESH(); mixer_phase(F, layer + 4 * rep); }
        SEAM(pb + 1); }
#endif
        for (int rep = 0; rep < REPS(2); ++rep) {
        if constexpr (ON(2)) if (IN(pb + 2)) {
            OPQ_WS(); unsigned char* wl = ws_ + WS_W + (size_t)layer * W_LAYER;
            pg8::Gemm g{Yb, (const bf16*)(wl + WO_BR), M, DM, DM}; pg8::StaticOrder S; S.init(M, DM, F.G, (int)blockIdx.x);
            pg8::EpiMix E{Gb, MIXb};
            pg8::gemm_phase<pg8::EpiMix, pg8::StaticOrder, true, true, false, true>(F.lds + RING_OFF, g, S, E, F.wv0);
        }
        SEAM(pb + 2); }
        if constexpr (ON(3)) if (IN(pb + 3)) {
            OPQ_WS(); unsigned char* wl = ws_ + WS_W + (size_t)layer * W_LAYER;
            pg8::Gemm g{MIXb, (const bf16*)(wl + WO_OUT), M, DM, DM}; pg8::StaticOrder S; S.init(M, DM, F.G, (int)blockIdx.x);
            pg8::EpiResid E{layer == 0 ? F.a->in[I_X] : nullptr, H};
            pg8::gemm_phase<pg8::EpiResid, pg8::StaticOrder, true, true, false, true>(F.lds + RING_OFF, g, S, E, F.wv0);
        }
        SEAM(pb + 3);
        for (int rep = 0; rep < REPS(4); ++rep) { if constexpr (ON(4)) if (IN(pb + 4)) { REFRESH(); OPQ_WS(); norm_phase<0, true>(F, H, F.a->in[I_NORM_FFN] + (size_t)layer * DM, U, nullptr, layer); }
        SEAM(pb + 4); }
        for (int rep = 0; rep < REPS(5); ++rep) {
        if constexpr (ON(5)) if (IN(pb + 5)) {
            OPQ_WS(); unsigned char* wl = ws_ + WS_W + (size_t)layer * W_LAYER;
            pg8::Gemm g{U, (const bf16*)(wl + WO_GU), M, NGU, DM}; pg8::StaticOrder S; S.init(M, NGU, F.G, (int)blockIdx.x);
            pg8::EpiSwiGLU E{HID};
            pg8::gemm_phase<pg8::EpiSwiGLU, pg8::StaticOrder, true, true, false, true>(F.lds + RING_OFF, g, S, E, F.wv0);
        }
        SEAM(pb + 5); }
        if constexpr (ON(6)) if (IN(pb + 6)) {
            OPQ_WS(); unsigned char* wl = ws_ + WS_W + (size_t)layer * W_LAYER;
            pg8::Gemm g{HID, (const bf16*)(wl + WO_DN), M, DM, DFF}; pg8::StaticOrder S; S.init(M, DM, F.G, (int)blockIdx.x);
            pg8::EpiResid E{nullptr, H};
            pg8::gemm_phase<pg8::EpiResid, pg8::StaticOrder, true, true, false, true>(F.lds + RING_OFF, g, S, E, F.wv0);
        }
        SEAM(pb + 6);
        if constexpr (ON(7)) if (IN(pb + 7)) { REFRESH(); OPQ_WS();
            if (layer + 1 < DEPTH) norm_phase<1, true>(F, H, F.a->in[I_NORM_MIX] + (size_t)(layer + 1) * DM, U, nullptr, layer + 1);
            else norm_phase<2, true>(F, H, F.a->in[I_NORM_FINAL], nullptr, F.out, 0);
        }
        if (layer + 1 < DEPTH) SEAM(pb + 7);
    }
#undef IN
#undef SEAM
#undef H
#undef U
#undef Zb
#undef Gb
#undef Yb
#undef MIXb
#undef HID
}

#ifndef DBG_STOP
#define DBG_STOP -1
#endif
#ifndef DBG_SRC
#define DBG_SRC 0
#endif
#ifndef DBG_COL
#define DBG_COL 0
#endif
__global__ void dbg_dump(const unsigned char* ws, float* out) {
    const size_t i = (size_t)blockIdx.x * blockDim.x + threadIdx.x; if (i >= (size_t)M * DM) return;
    const size_t r = i / DM, c = i % DM; float v;
    if (DBG_SRC == 0) v = bf2f(((const bf16*)(ws + WS_Y))[i]);
    else if (DBG_SRC == 1) v = bf2f(((const bf16*)(ws + WS_Z))[r * ZP + DBG_COL + c]);
    else if (DBG_SRC == 2) v = ((const float*)(ws + WS_H))[i];
    else if (DBG_SRC == 3) v = bf2f(((const bf16*)(ws + WS_MIX))[i]);
    else if (DBG_SRC == 4) v = bf2f(((const bf16*)(ws + WS_G))[r * GP + DBG_COL + c]);
    else v = bf2f(((const bf16*)(ws + WS_U))[i]);
    out[i] = v;
}
extern "C" void kernel_launch(void* const* d_in, const int* in_sizes, int n_in, void* d_out, int out_size, void* d_ws, size_t ws_size, hipStream_t stream) {
    static int grid = 0;
    if (grid == 0) {
        if (n_in != 25 || in_sizes[0] != M * DM || out_size != M * DM || ws_size < WS_END) { fprintf(stderr, "kernel_launch: unexpected shapes (n_in %d, in0 %d, out %d, ws %zu); nothing launched\n", n_in, n_in > 0 ? in_sizes[0] : -1, out_size, ws_size); grid = -1; return; }
        int dev = 0, cus = 0, per_cu = 0;
        if (hipGetDevice(&dev) != hipSuccess || hipDeviceGetAttribute(&cus, hipDeviceAttributeMultiprocessorCount, dev) != hipSuccess) { grid = -1; return; }
        if (hipFuncSetAttribute((const void*)mk_fwd, hipFuncAttributeMaxDynamicSharedMemorySize, LDS_BYTES) != hipSuccess) { fprintf(stderr, "kernel_launch: hipFuncSetAttribute failed\n"); grid = -1; return; }
        if (hipOccupancyMaxActiveBlocksPerMultiprocessor(&per_cu, (const void*)mk_fwd, NTHREADS, LDS_BYTES) != hipSuccess || per_cu < 1) { fprintf(stderr, "kernel_launch: occupancy query says %d workgroups per CU\n", per_cu); }
        (void)hipGetLastError();
        grid = cus;
    }
    if (grid < 0) return;
    if (hipMemsetAsync((char*)d_ws + WS_CTL, 0, CTL_ZERO_BYTES, stream) != hipSuccess) return;
    Args a{};
    for (int i = 0; i < 25; ++i) a.in[i] = (const float*)d_in[i];
    a.out = (float*)d_out; a.ws = (unsigned char*)d_ws;
#if MK_SPLIT
    for (int p = 0; p < NPHASES; ++p) { if (DBG_STOP >= 0 && p > DBG_STOP) break; a.ph_lo = p; a.ph_hi = p + 1; hipLaunchKernelGGL(mk_fwd, dim3(grid), dim3(NTHREADS), LDS_BYTES, stream, a); }
    if (DBG_STOP >= 0) hipLaunchKernelGGL(dbg_dump, dim3((M * DM + 255) / 256), dim3(256), 0, stream, (const unsigned char*)d_ws, (float*)d_out);
#else
    a.ph_lo = 0; a.ph_hi = NPHASES;
    hipLaunchKernelGGL(mk_fwd, dim3(grid), dim3(NTHREADS), LDS_BYTES, stream, a);
#endif
    const hipError_t le = hipPeekAtLastError();
    if (le != hipSuccess) fprintf(stderr, "kernel_launch: launch failed: %s\n", hipGetErrorName(le));
}
```

```cpp
#include <hip/hip_runtime.h>
#include <cstdio>
#include <cstdint>
namespace pg8 {
#define PG8_LAS __attribute__((address_space(3)))
typedef unsigned short bf16_t;
typedef short bf16x8 __attribute__((ext_vector_type(8)));
typedef float f32x4 __attribute__((ext_vector_type(4)));
typedef unsigned u32x4 __attribute__((ext_vector_type(4)));
constexpr int BM = 256, BK = 64, HALF = 128, HTB = HALF * BK * 2  , STAGE_BYTES = 8 * HTB, NXCD = 8, WGM = 8;

__host__ __device__ __forceinline__ int lds_byte(int r, int c) { const int st = (r >> 4) * 2 + (c >> 5), rr = r & 15, cc = c & 31, ob = rr * 64 + cc * 2; return st * 1024 + (ob ^ (((ob >> 9) & 1) << 5)); }
__host__ __device__ __forceinline__ void stage_rc(int b, int& R, int& C) { const int st = b / 1024, sb = b % 1024, swz = sb ^ (((sb >> 9) & 1) << 5); R = (st >> 1) * 16 + swz / 64; C = (st & 1) * 32 + (swz % 64) / 2; }
__host__ __device__ __forceinline__ size_t img_a(int row, int col, int nkt) { return ((((size_t)(row >> 8) * nkt + (col >> 6)) * 2 + ((row >> 7) & 1)) << 14) + (size_t)lds_byte(row & 127, col & 63); }
__host__ __device__ __forceinline__ int perm32(int rho) { const int n = rho >> 4, i = rho & 15; return 8 * (i >> 2) + 4 * n + (i & 3); }

struct Unit { int pm, pn; };
struct Gemm { const bf16_t* A; const bf16_t* Bt; int M, N, K; };

struct StaticOrder {
    int nM, nN, nwg, G, c;
    __host__ __device__ void init(int M, int N, int G_, int c_) { nM = M / BM; nN = N / BM; nwg = nM * nN; G = G_; c = c_; }
    __host__ __device__ bool next(int i, Unit& u) const {
        const long L = (long)i * G + c; if (L >= nwg) return false;
        int wgid = (int)L; { const int q = nwg / NXCD, r = nwg % NXCD, xcd = wgid % NXCD, off = wgid / NXCD; wgid = (xcd < r ? xcd * (q + 1) : r * (q + 1) + (xcd - r) * q) + off; }
        const int nig = WGM * nN, gid = wgid / nig, fm = gid * WGM, gsz = (nM - fm) < WGM ? (nM - fm) : WGM;
        u.pm = fm + ((wgid % nig) % gsz); u.pn = (wgid % nig) / gsz; return true;
    }
    __device__ __forceinline__ void a_ready(const Unit&) const {}
    __device__ __forceinline__ void done(const Unit&) const {}
};

typedef float f32x2c __attribute__((ext_vector_type(2))); typedef __bf16 bf16x2c __attribute__((ext_vector_type(2)));
__device__ __forceinline__ unsigned cvt_pk_bf16(float lo, float hi) { f32x2c v = {lo, hi}; bf16x2c b = __builtin_convertvector(v, bf16x2c); return __builtin_bit_cast(unsigned, b); }
typedef float f32x2 __attribute__((ext_vector_type(2)));

#ifndef DBG_EPI2
#define DBG_EPI2 0
#endif
typedef unsigned u32x2v __attribute__((ext_vector_type(2)));
__device__ __forceinline__ float sigmoid_f(float x, float nl2e) { return __builtin_amdgcn_rcpf(1.0f + __builtin_amdgcn_exp2f(nl2e * x)); }
#define PG8_NL2E(v) float v = -1.4426950408889634f; asm volatile("" : "+v"(v))

__device__ __forceinline__ void bf8_to_f32(const u32x4 w, float (&f)[8]) {
    f[0] = __builtin_bit_cast(float, w.x << 16); f[1] = __builtin_bit_cast(float, w.x & 0xffff0000u);
    f[2] = __builtin_bit_cast(float, w.y << 16); f[3] = __builtin_bit_cast(float, w.y & 0xffff0000u);
    f[4] = __builtin_bit_cast(float, w.z << 16); f[5] = __builtin_bit_cast(float, w.z & 0xffff0000u);
    f[6] = __builtin_bit_cast(float, w.w << 16); f[7] = __builtin_bit_cast(float, w.w & 0xffff0000u);
}
struct EpiZ {
    static constexpr bool PERM = true, AFTER_DRAIN = false, EPI2 = false; static constexpr int KSEG = 0;
    bf16_t* Z;
    __device__ __forceinline__ void operator()(const f32x4 (&acc)[2][2][4][2], const Unit& u, int wr, int wc, int fr, int fq) const {
        const int row0 = u.pm * BM + wr * 64 + fr, col0 = u.pn * BM + wc * 32 + 8 * fq;
#pragma unroll
        for (int ai = 0; ai < 2; ++ai)
#pragma unroll
            for (int m = 0; m < 4; ++m) { bf16_t* rowp = Z + (size_t)(row0 + ai * HALF + m * 16) * 4864 + col0;
#pragma unroll
                for (int bj = 0; bj < 2; ++bj) { const f32x4 v0 = acc[ai][bj][m][0], v1 = acc[ai][bj][m][1];
                    u32x4 w; w.x = cvt_pk_bf16(v0[0], v0[1]); w.y = cvt_pk_bf16(v0[2], v0[3]); w.z = cvt_pk_bf16(v1[0], v1[1]); w.w = cvt_pk_bf16(v1[2], v1[3]);
                    *(u32x4*)(rowp + bj * HALF) = w; } }
    }
};
struct EpiG {
    static constexpr bool PERM = true, AFTER_DRAIN = false, EPI2 = (DBG_EPI2 == 1); static constexpr int KSEG = 0;
    bf16_t* G; const float* bgate; float sc;
    __device__ __forceinline__ void operator()(const f32x4 (&acc)[2][2][4][2], const Unit& u, int wr, int wc, int fr, int fq) const {
        {   unsigned ones_ = ~0u; asm volatile("" : "+s"(ones_));
            const int ln_ = (int)__builtin_amdgcn_mbcnt_hi(ones_, __builtin_amdgcn_mbcnt_lo(ones_, 0u)); fr = ln_ & 15; fq = ln_ >> 4; }
        const int oc = u.pn * 64 + wc * 16 + 4 * fq;
        bf16_t* gfr = G + ((size_t)(u.pm * 8 + (u.pn >> 2)) * 4) * 65536 + 8 * ((((u.pn >> 1) & 1) * 512 + wr * 256 + (2 * (u.pn & 1) + (wc >> 1)) * 64) + 16 * (2 * (wc & 1) + (fq >> 1)) + fr);
        PG8_NL2E(nl2e);
        f32x4 bv[4];
#pragma unroll
        for (int k = 0; k < 4; ++k) bv[k] = *(const f32x4*)(bgate + k * 2048 + oc) * nl2e;
#pragma unroll
        for (int ai = 0; ai < 2; ++ai)
#pragma unroll
            for (int m = 0; m < 4; ++m) {
                float sc_ = sc * nl2e; asm volatile("" : "+v"(sc_));
                f32x4 d[4], g[4];
#pragma unroll
                for (int k = 0; k < 4; ++k) { const f32x4 x = acc[ai][k >> 1][m][k & 1] * sc_ + bv[k];
#pragma unroll
                    for (int e = 0; e < 4; ++e) { d[k][e] = fminf(1.0f + __builtin_amdgcn_exp2f(x[e]), 1e30f); g[k][e] = __builtin_amdgcn_rcpf(d[k][e]); } }
                u32x2v w[4];
#pragma unroll
                for (int k = 0; k < 4; ++k) { const f32x4 o = (k < 3) ? g[k] * d[k < 3 ? k + 1 : 3] : g[3]; w[k].x = cvt_pk_bf16(o[0], o[1]); w[k].y = cvt_pk_bf16(o[2], o[3]); }
#pragma unroll
                for (int q = 0; q < 2; ++q) {
                    const auto r0 = __builtin_amdgcn_permlane16_swap(w[2 + q].x, w[q].x, false, false), r1 = __builtin_amdgcn_permlane16_swap(w[2 + q].y, w[q].y, false, false);
                    u32x4 v; v.x = r0[0]; v.y = r1[0]; v.z = r0[1]; v.w = r1[1];
                    __builtin_nontemporal_store(v, (__attribute__((address_space(1))) u32x4*)(gfr + (size_t)((fq & 1) ? q : 2 + q) * 65536 + (ai * 4 + m) * 8192));
                    if (q == 1) asm volatile("" :: "v"(v.x), "v"(v.y), "v"(v.z), "v"(v.w) : "memory"); } }
    }
};

struct EpiResid {
    static constexpr bool PERM = true, AFTER_DRAIN = false, EPI2 = false; static constexpr int KSEG = 0;
    const float* srcx; bf16_t* H;
    __device__ __forceinline__ void operator()(const f32x4 (&acc)[2][2][4][2], const Unit& u, int wr, int wc, int fr, int fq) const {
        const int row0 = u.pm * BM + wr * 64 + fr, col0 = u.pn * BM + wc * 32 + 8 * fq;
#pragma unroll
        for (int ai = 0; ai < 2; ++ai) {
            f32x4 r[4][2][2];
            if (srcx) {
#pragma unroll
                for (int m = 0; m < 4; ++m) { const size_t off = (size_t)(row0 + ai * HALF + m * 16) * 2048 + col0;
#pragma unroll
                    for (int bj = 0; bj < 2; ++bj)
#pragma unroll
                        for (int n = 0; n < 2; ++n) r[m][bj][n] = *(const f32x4*)(srcx + off + bj * HALF + 4 * n); }
            } else {
                u32x4 hb[4][2];
#pragma unroll
                for (int m = 0; m < 4; ++m)
#pragma unroll
                    for (int bj = 0; bj < 2; ++bj) hb[m][bj] = *(const u32x4*)((const char*)H + img_a(row0 + ai * HALF + m * 16, col0 + bj * HALF, 32));
#pragma unroll
                for (int m = 0; m < 4; ++m)
#pragma unroll
                    for (int bj = 0; bj < 2; ++bj) { float f[8]; bf8_to_f32(hb[m][bj], f);
                        r[m][bj][0] = (f32x4){f[0], f[1], f[2], f[3]}; r[m][bj][1] = (f32x4){f[4], f[5], f[6], f[7]}; }
            }
#pragma unroll
            for (int m = 0; m < 4; ++m)
#pragma unroll
                for (int bj = 0; bj < 2; ++bj) { const f32x4 v0 = r[m][bj][0] + acc[ai][bj][m][0], v1 = r[m][bj][1] + acc[ai][bj][m][1];
                    u32x4 w; w.x = cvt_pk_bf16(v0[0], v0[1]); w.y = cvt_pk_bf16(v0[2], v0[3]); w.z = cvt_pk_bf16(v1[0], v1[1]); w.w = cvt_pk_bf16(v1[2], v1[3]);
                    *(u32x4*)((char*)H + img_a(row0 + ai * HALF + m * 16, col0 + bj * HALF, 32)) = w; }
        }
    }
};

struct EpiSwiGLU {
    static constexpr bool PERM = true, AFTER_DRAIN = false, EPI2 = (DBG_EPI2 == 2); static constexpr int KSEG = 0;
    bf16_t* HID;
    __device__ __forceinline__ void operator()(const f32x4 (&acc)[2][2][4][2], const Unit& u, int wr, int wc, int fr, int fq) const {
        const int row0 = u.pm * BM + wr * 64 + fr, col0 = u.pn * HALF + wc * 32 + 8 * fq;
        PG8_NL2E(nl2e);
#pragma unroll
        for (int ai = 0; ai < 2; ++ai)
#pragma unroll
            for (int m = 0; m < 4; ++m) { bf16_t* rowp = (bf16_t*)((char*)HID + img_a(row0 + ai * HALF + m * 16, col0, 88));
                f32x4 v0, v1;
#pragma unroll
                for (int e = 0; e < 4; ++e) { const float g0 = acc[ai][0][m][0][e], g1 = acc[ai][0][m][1][e];
                    v0[e] = g0 * sigmoid_f(g0, nl2e) * acc[ai][1][m][0][e]; v1[e] = g1 * sigmoid_f(g1, nl2e) * acc[ai][1][m][1][e]; }
                u32x4 w; w.x = cvt_pk_bf16(v0[0], v0[1]); w.y = cvt_pk_bf16(v0[2], v0[3]); w.z = cvt_pk_bf16(v1[0], v1[1]); w.w = cvt_pk_bf16(v1[2], v1[3]);
                *(u32x4*)rowp = w; }
    }
};

struct EpiMix {
    static constexpr bool PERM = true, AFTER_DRAIN = false, EPI2 = (DBG_EPI2 == 3); static constexpr int KSEG = 8;
    const bf16_t* G; bf16_t* MIX;
    __device__ __forceinline__ void kseg(f32x4 (&acc)[2][2][4][2], const Unit& u, int i, int wr, int wc, int fr, int fq) const {
        asm volatile("" : "+v"(fr), "+v"(fq));
        const bf16_t* gfr = G + ((size_t)(u.pm * 8 + u.pn) * 4 + (i - 1)) * 65536 + 8 * (wr * 256 + wc * 64 + 16 * fq + fr);
        u32x4 wv[2][4][2];
#pragma unroll
        for (int ai = 0; ai < 2; ++ai)
#pragma unroll
            for (int m = 0; m < 4; ++m)
#pragma unroll
                for (int bj = 0; bj < 2; ++bj) wv[ai][m][bj] = __builtin_nontemporal_load((const __attribute__((address_space(1))) u32x4*)(gfr + (ai * 4 + m) * 8192 + bj * 4096));
#pragma unroll
        for (int ai = 0; ai < 2; ++ai) {
#pragma unroll
            for (int m = 0; m < 4; ++m)
#pragma unroll
                for (int bj = 0; bj < 2; ++bj) { float f[8]; bf8_to_f32(wv[ai][m][bj], f);
#pragma unroll
                    for (int e = 0; e < 4; ++e) { acc[ai][bj][m][0][e] *= f[e]; acc[ai][bj][m][1][e] *= f[4 + e]; } }
        }
        asm volatile("" ::: "memory");
    }
    __device__ __forceinline__ void operator()(const f32x4 (&acc)[2][2][4][2], const Unit& u, int wr, int wc, int fr, int fq) const {
        const int row0 = u.pm * BM + wr * 64 + fr, col0 = u.pn * BM + wc * 32 + 8 * fq;
        const bf16_t* gfr = G + ((size_t)(u.pm * 8 + u.pn) * 4 + 3) * 65536 + 8 * (wr * 256 + wc * 64 + 16 * fq + fr);
#pragma unroll
        for (int ai = 0; ai < 2; ++ai) {
            u32x4 wg[4][2];
#pragma unroll
            for (int m = 0; m < 4; ++m)
#pragma unroll
                for (int bj = 0; bj < 2; ++bj) wg[m][bj] = __builtin_nontemporal_load((const __attribute__((address_space(1))) u32x4*)(gfr + (ai * 4 + m) * 8192 + bj * 4096));
#pragma unroll
            for (int m = 0; m < 4; ++m) { const size_t ro = (size_t)(row0 + ai * HALF + m * 16);
#pragma unroll
                for (int bj = 0; bj < 2; ++bj) {
                    float g[8]; bf8_to_f32(wg[m][bj], g);
                    const f32x4 a0 = acc[ai][bj][m][0], a1 = acc[ai][bj][m][1];
                    u32x4 w; w.x = cvt_pk_bf16(a0[0] * g[0], a0[1] * g[1]); w.y = cvt_pk_bf16(a0[2] * g[2], a0[3] * g[3]);
                             w.z = cvt_pk_bf16(a1[0] * g[4], a1[1] * g[5]); w.w = cvt_pk_bf16(a1[2] * g[6], a1[3] * g[7]);
                    *(u32x4*)((char*)MIX + img_a((int)ro, col0 + bj * HALF, 32)) = w; } }
        }
    }
};


template <class Epi, class Sched, bool ALIGN_EPI = false, bool SP2 = false, bool FP8 = false, bool AIMG = false>
__device__ __forceinline__ void gemm_phase(PG8_LAS unsigned char* lds, const Gemm g, const Sched& S, const Epi& E, const int wv0) {
    unsigned ones_ = ~0u; asm volatile("" : "+s"(ones_));
    int tid_ = wv0 * 64 + (int)__builtin_amdgcn_mbcnt_hi(ones_, __builtin_amdgcn_mbcnt_lo(ones_, 0u)); asm volatile("" : "+v"(tid_));
    const int tid = tid_, wid = __builtin_amdgcn_readfirstlane(tid >> 6), lane = tid & 63, wr = wid >> 2, wc = wid & 3, fr = lane & 15, fq = lane >> 4;
    const int K = g.K, nt = K / BK;
    unsigned voffA[2], voffB[2];
#pragma unroll
    for (int i = 0; i < 2; ++i) { int R, C; stage_rc(tid * 16 + i * 8192, R, C); const int Rb = Epi::PERM ? ((R & ~31) + perm32(R & 31)) : R;
        voffB[i] = (unsigned)(tid * 16 + i * 8192); voffA[i] = AIMG ? voffB[i] : (unsigned)(R * K + C) * 2u; (void)Rb; }
    const size_t kstep = AIMG ? (size_t)32768 : (size_t)(BK * 2);
    const size_t hstep = AIMG ? (size_t)16384 : (size_t)HALF * K * 2;
    const size_t tstep = (size_t)nt * 32768;
    const size_t kstepB = 32768, hstepB = 16384, tstepB = (size_t)nt * 32768;
    const unsigned ldsw = (unsigned)wid * 1024u;
    const int aoff = lds_byte(wr * 64 + fr, fq * 8), boff = lds_byte(wc * 32 + fr, fq * 8);
#define PG8_SA(b, h) (((b) * 2 + (h)) * HTB)
#define PG8_SB(b, h) ((4 + (b) * 2 + (h)) * HTB)
#define PG8_STAGE(bufoff, gbase, voff) do { _Pragma("unroll") for (int _i = 0; _i < 2; ++_i) { unsigned vo_ = (voff)[_i]; if constexpr (FP8) asm volatile("" : "+v"(vo_));     \
        __builtin_amdgcn_global_load_lds((const unsigned*)((const char*)(gbase) + vo_), (PG8_LAS unsigned*)(lds + (bufoff) + ldsw + _i * 8192), 16, 0, 0); } } while (0)
#define PG8_LDA(dst, b, h) do { _Pragma("unroll") for (int m = 0; m < 4; ++m) _Pragma("unroll") for (int k = 0; k < 2; ++k) dst[m][k] = *(const PG8_LAS bf16x8*)(lds + PG8_SA(b, h) + aoff + m * 2048 + k * 1024); } while (0)
#define PG8_LDB(dst, b, h) do { _Pragma("unroll") for (int n = 0; n < 2; ++n) _Pragma("unroll") for (int k = 0; k < 2; ++k) dst[n][k] = *(const PG8_LAS bf16x8*)(lds + PG8_SB(b, h) + boff + n * 2048 + k * 1024); } while (0)
#define PG8_MMA(ai, bj, At, Bt) do { __builtin_amdgcn_s_setprio(1); _Pragma("unroll") for (int m = 0; m < 4; ++m) _Pragma("unroll") for (int n = 0; n < 2; ++n) { \
        if constexpr (FP8) { typedef int v4i_ __attribute__((ext_vector_type(4))); typedef int v8i_ __attribute__((ext_vector_type(8))); \
            const v4i_ b0_ = __builtin_bit_cast(v4i_, Bt[n][0]), b1_ = __builtin_bit_cast(v4i_, Bt[n][1]), a0_ = __builtin_bit_cast(v4i_, At[m][0]), a1_ = __builtin_bit_cast(v4i_, At[m][1]); \
            const v8i_ bb_ = (v8i_){b0_[0], b0_[1], b0_[2], b0_[3], b1_[0], b1_[1], b1_[2], b1_[3]}, aa_ = (v8i_){a0_[0], a0_[1], a0_[2], a0_[3], a1_[0], a1_[1], a1_[2], a1_[3]}; \
            acc[ai][bj][m][n] = __builtin_amdgcn_mfma_scale_f32_16x16x128_f8f6f4(bb_, aa_, acc[ai][bj][m][n], 0, 0, 0, 0x7f7f7f7f, 0, 0x7f7f7f7f); } \
        else { _Pragma("unroll") for (int k = 0; k < 2; ++k) acc[ai][bj][m][n] = __builtin_amdgcn_mfma_f32_16x16x32_bf16(Bt[n][k], At[m][k], acc[ai][bj][m][n], 0, 0, 0); } } \
        __builtin_amdgcn_s_setprio(0); } while (0)
#define PG8_WAIT_V(n) asm volatile("s_waitcnt vmcnt(" #n ")" ::: "memory")
#define PG8_WAIT_L(n) asm volatile("s_waitcnt lgkmcnt(" #n ")" ::: "memory")
#define PG8_BAR __builtin_amdgcn_s_barrier()
#define PG8_SCHED __builtin_amdgcn_sched_barrier(0)
    Unit cur, nxt; int ui = 0;
    if (!S.next(0, cur)) return;
    f32x4 acc[2][2][4][2];
#pragma unroll
    for (int a = 0; a < 2; ++a)
#pragma unroll
        for (int b = 0; b < 2; ++b)
#pragma unroll
            for (int m = 0; m < 4; ++m)
#pragma unroll
                for (int n = 0; n < 2; ++n) acc[a][b][m][n] = (f32x4){0.f, 0.f, 0.f, 0.f};
    bf16x8 At[4][2], B0[2][2], B1[2][2];
    const char* cA = (const char*)g.A + (size_t)cur.pm * tstep; const char* cB = (const char*)g.Bt + (size_t)cur.pn * tstepB;
    S.a_ready(cur);
    if constexpr (SP2) {
        PG8_STAGE(PG8_SB(0, 0), cB, voffB); PG8_STAGE(PG8_SB(0, 1), cB + hstepB, voffB); PG8_STAGE(PG8_SA(0, 0), cA, voffA); PG8_STAGE(PG8_SA(0, 1), cA + hstep, voffA);
        if (wr == 1) PG8_BAR;
        PG8_WAIT_V(2); PG8_BAR;
        PG8_STAGE(PG8_SB(1, 0), cB + kstepB, voffB); PG8_STAGE(PG8_SA(1, 0), cA + kstep, voffA); PG8_STAGE(PG8_SB(1, 1), cB + hstepB + kstepB, voffB);
        PG8_WAIT_V(6); PG8_BAR;
    } else {
        PG8_STAGE(PG8_SB(0, 0), cB, voffB); PG8_STAGE(PG8_SA(0, 0), cA, voffA); PG8_STAGE(PG8_SB(0, 1), cB + hstepB, voffB); PG8_STAGE(PG8_SA(0, 1), cA + hstep, voffA);
        if (wr == 1) PG8_BAR;
        PG8_WAIT_V(4); PG8_BAR;
        PG8_STAGE(PG8_SB(1, 0), cB + kstepB, voffB); PG8_STAGE(PG8_SA(1, 0), cA + kstep, voffA); PG8_STAGE(PG8_SB(1, 1), cB + hstepB + kstepB, voffB);
        PG8_WAIT_V(6); PG8_BAR;
    }
    for (;;) {
        const bool has_next = S.next(ui + 1, nxt);
        const char* nA = has_next ? (const char*)g.A + (size_t)nxt.pm * tstep : cA; const char* nB = has_next ? (const char*)g.Bt + (size_t)nxt.pn * tstepB : cB;
        for (int t = 0; t < nt; t += 2) {
            if constexpr (Epi::KSEG > 0) { if (t != 0 && (t % Epi::KSEG) == 0) E.kseg(acc, cur, t / Epi::KSEG, wr, wc, fr, fq); }
            const bool last = (t == nt - 2);
            const char* a1 = cA + (size_t)(t + 1) * kstep;
            const char* a2 = last ? nA : cA + (size_t)(t + 2) * kstep; const char* b2 = last ? nB : cB + (size_t)(t + 2) * kstepB;
            const char* a3 = a2 + kstep; const char* b3 = b2 + kstepB;
            if (last && has_next) S.a_ready(nxt);
            if constexpr (SP2) {
            PG8_LDB(B0, 0, 0); PG8_LDB(B1, 0, 1); PG8_SCHED; PG8_LDA(At, 0, 0); PG8_STAGE(PG8_SA(1, 1), a1 + hstep, voffA);
            PG8_WAIT_V(8); PG8_WAIT_L(0); PG8_BAR; PG8_MMA(0, 0, At, B0); PG8_MMA(0, 1, At, B1); PG8_BAR; PG8_SCHED;
            PG8_LDA(At, 0, 1); PG8_STAGE(PG8_SB(0, 0), b2, voffB); PG8_STAGE(PG8_SB(0, 1), b2 + hstepB, voffB); PG8_STAGE(PG8_SA(0, 0), a2, voffA);
            PG8_WAIT_V(8); PG8_WAIT_L(0); PG8_BAR; PG8_MMA(1, 0, At, B0); PG8_MMA(1, 1, At, B1); PG8_BAR; PG8_SCHED;
            PG8_LDB(B0, 1, 0); PG8_LDB(B1, 1, 1); PG8_SCHED; PG8_LDA(At, 1, 0); PG8_STAGE(PG8_SA(0, 1), a2 + hstep, voffA);
            PG8_WAIT_V(8); PG8_WAIT_L(0); PG8_BAR; PG8_MMA(0, 0, At, B0); PG8_MMA(0, 1, At, B1); PG8_BAR; PG8_SCHED;
            PG8_LDA(At, 1, 1); PG8_STAGE(PG8_SB(1, 0), b3, voffB); PG8_STAGE(PG8_SB(1, 1), b3 + hstepB, voffB); PG8_STAGE(PG8_SA(1, 0), a3, voffA);
            PG8_WAIT_V(8); PG8_WAIT_L(0); PG8_BAR; PG8_MMA(1, 0, At, B0); PG8_MMA(1, 1, At, B1); PG8_BAR; PG8_SCHED;
            } else {
            PG8_LDB(B0, 0, 0); PG8_SCHED; PG8_LDA(At, 0, 0); PG8_STAGE(PG8_SA(1, 1), a1 + hstep, voffA);
            PG8_WAIT_L(8); PG8_BAR; PG8_WAIT_L(0); PG8_MMA(0, 0, At, B0); PG8_BAR; PG8_SCHED;
            PG8_LDB(B1, 0, 1); PG8_STAGE(PG8_SB(0, 0), b2, voffB);
            PG8_BAR; PG8_WAIT_L(0); PG8_MMA(0, 1, At, B1); PG8_BAR;
            PG8_LDA(At, 0, 1); PG8_STAGE(PG8_SA(0, 0), a2, voffA);
            PG8_BAR; PG8_WAIT_L(0); PG8_MMA(1, 0, At, B0); PG8_BAR; PG8_SCHED;
            PG8_STAGE(PG8_SB(0, 1), b2 + hstepB, voffB);
            PG8_WAIT_V(6); PG8_BAR; PG8_MMA(1, 1, At, B1); PG8_BAR;
            PG8_LDB(B0, 1, 0); PG8_SCHED; PG8_LDA(At, 1, 0); PG8_STAGE(PG8_SA(0, 1), a2 + hstep, voffA);
            PG8_WAIT_L(8); PG8_BAR; PG8_WAIT_L(0); PG8_MMA(0, 0, At, B0); PG8_BAR; PG8_SCHED;
            PG8_LDB(B1, 1, 1); PG8_STAGE(PG8_SB(1, 0), b3, voffB);
            PG8_BAR; PG8_WAIT_L(0); PG8_MMA(0, 1, At, B1); PG8_BAR;
            PG8_LDA(At, 1, 1); PG8_STAGE(PG8_SA(1, 0), a3, voffA);
            PG8_BAR; PG8_WAIT_L(0); PG8_MMA(1, 0, At, B0); PG8_BAR; PG8_SCHED;
            PG8_STAGE(PG8_SB(1, 1), b3 + hstepB, voffB);
            PG8_WAIT_V(6); PG8_BAR; PG8_MMA(1, 1, At, B1); PG8_BAR;
            }
        }
        if constexpr (ALIGN_EPI) { if (wr == 0) PG8_BAR; }
        if constexpr (!Epi::AFTER_DRAIN) { E(acc, cur, wr, wc, fr, fq); if constexpr (Epi::EPI2) { asm volatile("" ::: "memory"); E(acc, cur, wr, wc, fr, fq); } S.done(cur); }
        if (!has_next) break;
#pragma unroll
        for (int a = 0; a < 2; ++a)
#pragma unroll
            for (int b = 0; b < 2; ++b)
#pragma unroll
                for (int m = 0; m < 4; ++m)
#pragma unroll
                    for (int n = 0; n < 2; ++n) acc[a][b][m][n] = (f32x4){0.f, 0.f, 0.f, 0.f};
        cur = nxt; cA = nA; cB = nB; ++ui;
        if constexpr (ALIGN_EPI) { if (wr == 1) PG8_BAR; }
    }
    PG8_WAIT_V(0);
    if constexpr (!ALIGN_EPI) { if (wr == 0) PG8_BAR; }
    PG8_BAR;
    if constexpr (Epi::AFTER_DRAIN) { E.fused(acc, cur, wr, wc, fr, fq, lds, wid, lane); S.done(cur); }
#undef PG8_SA
#undef PG8_SB
#undef PG8_STAGE
#undef PG8_LDA
#undef PG8_LDB
#undef PG8_MMA
#undef PG8_WAIT_V
#undef PG8_WAIT_L
#undef PG8_BAR
#undef PG8_SCHED
}
}


constexpr int NWAVES = 8, NTHREADS = 512;
constexpr int BATCH = 4, SEQ = 4096, DM = 2048, DEPTH = 4, M = BATCH * SEQ;
constexpr int IN_COLS = 13060, NIN = 13056, ZP = 4864, GP = 8192, DFF = 5632, NGU = 2 * DFF;
constexpr float RMS_EPS = 1e-6f, LOG2E = 1.4426950408889634f, NEGBIG = -1e30f;
constexpr int ZC_AQ = 0, ZC_AK = 512, ZC_AV = 1024, ZC_BX = 1536, ZC_BG = 2048, ZC_CQ = 2560, ZC_CK = 3072, ZC_CV = 3584, ZC_DQ = 4096, ZC_DK = 4608, ZC_DV = 4736;

constexpr size_t MiB = 1u << 20;
constexpr size_t WS_CTL = 0, CTL_ZERO_BYTES = 2 * MiB;
constexpr size_t WS_GRAN = 1 * MiB;
constexpr size_t WS_KMAX = 512 * 1024;
constexpr size_t WS_WCF = 2 * MiB;
constexpr size_t WS_LRUK = 2 * MiB + 512 * 1024;
constexpr size_t WS_LOGF = 3 * MiB;
constexpr size_t WS_W = 4 * MiB, W_LAYER = 133 * MiB;
constexpr size_t WO_IN = 0, WO_BR = 51 * MiB, WO_OUT = 59 * MiB, WO_GU = 67 * MiB, WO_DN = 111 * MiB;
constexpr size_t WS_H = WS_W + DEPTH * W_LAYER;
constexpr size_t WS_U = WS_H + 128 * MiB;
constexpr size_t WS_Z = WS_U + 64 * MiB;
constexpr size_t WS_G = WS_Z + 152 * MiB;
constexpr size_t WS_Y = WS_G + 256 * MiB;
constexpr size_t WS_MIX = WS_Y + 64 * MiB;
constexpr size_t WS_OSCR = WS_MIX + 64 * MiB;
constexpr size_t WS_HL = WS_OSCR + 32 * MiB;
constexpr size_t WS_PL = WS_HL + 32 * MiB;
constexpr size_t WS_W8 = WS_PL + 32 * MiB;
constexpr size_t WS_U8 = WS_W8 + 4 * 16 * MiB;
constexpr size_t WS_END = WS_U8 + 32 * MiB;
constexpr float FP8_SA = 16.f, FP8_SW = 64.f;
static_assert((size_t)M * ZP * 2 <= 152 * MiB && (size_t)M * DFF * 2 <= 256 * MiB && (size_t)NIN * DM * 2 == 51 * MiB && (size_t)NGU * DM * 2 == 44 * MiB, "d_ws map");
constexpr int CW_BAR = 4096;
constexpr int CW_Q = 16384;

constexpr int RING_OFF = 0, RING_BYTES = 131072;
constexpr int LDSCTL_OFF = RING_BYTES, MISC_OFF = LDSCTL_OFF + 320;
constexpr int LDS_BYTES = 131072 + 1024 + 16384 + 1024;
constexpr int MX_KIMG = 0, MX_VIMG = 65536, MX_BIAS = LDSCTL_OFF + 1024, MX_SCR = MX_BIAS + 16384;
static_assert(MX_SCR + 1024 <= LDS_BYTES && MISC_OFF + 64 <= LDSCTL_OFF + 1024, "mixer LDS map");
constexpr int LR_P = 68;
constexpr int LR_XC = 0, LR_A = 34816, LR_U = 69632, LR_WT = 104448, LR_SEGA = 122880, LR_SEGH = 124928, LR_CARRY = 126976, LR_CARRYP = 127488, LR_HIN = 128000;
static_assert(LR_HIN + 256 <= RING_BYTES && LR_WT + 128 * 144 <= LR_SEGA, "LRU LDS map");

#define XB_LAS __attribute__((address_space(3)))


#define GAS __attribute__((address_space(1)))
#define LAS __attribute__((address_space(3)))
typedef unsigned short bf16;
typedef unsigned v4u __attribute__((ext_vector_type(4)));
typedef float f32x4 __attribute__((ext_vector_type(4)));
typedef short bf16x8 __attribute__((ext_vector_type(8)));
typedef GAS unsigned gu32;
typedef GAS unsigned long long gu64;
#define RLX_AGENT __ATOMIC_RELAXED, __HIP_MEMORY_SCOPE_AGENT
#define LDS_WAIT() asm volatile("s_waitcnt lgkmcnt(0)" ::: "memory")
#define VM_WAIT() asm volatile("s_waitcnt vmcnt(0)" ::: "memory")
__device__ __forceinline__ unsigned long long rt() { return __builtin_amdgcn_s_memrealtime(); }
__device__ __forceinline__ unsigned f2bf(float f) { unsigned u = __builtin_bit_cast(unsigned, f); return (u + 0x7fffu + ((u >> 16) & 1u)) >> 16; }
__device__ __forceinline__ unsigned pk2(float lo, float hi) { return f2bf(lo) | (f2bf(hi) << 16); }

#define XB_TMO      128
#define XB_XCNT(j)  (256  + 64 * (j))
#define XB_XSUB(j)  (1280 + 64 * (j))
#define XB_XGEN(j)  (2304 + 64 * (j))
#define XB_TOP      3328
#define XB_TOPGEN   3392
#define XCD_BAR_WORDS 3456
#define XB_SPIN_CAP (1u << 18)

__device__ __forceinline__ unsigned xb_ld(unsigned* p)              { return __hip_atomic_load(p, __ATOMIC_RELAXED, __HIP_MEMORY_SCOPE_AGENT); }
__device__ __forceinline__ unsigned xb_add(unsigned* p, unsigned v) { unsigned one; asm volatile("v_mov_b32 %0, 1" : "=v"(one)); (void)v; return __hip_atomic_fetch_add(p, one, __ATOMIC_RELAXED, __HIP_MEMORY_SCOPE_AGENT); }
__device__ __forceinline__ unsigned xb_xcc_id() { return (unsigned)__builtin_amdgcn_s_getreg((3 << 11) | 20) & 0xFu; }
#define XB_SPIN(cond, bar) do { unsigned _sp = 0; while (cond) { __builtin_amdgcn_s_sleep(1); \
    if ((++_sp & 255u) == 0u) { if (xb_ld(&(bar)[XB_TMO])) break; if (_sp > XB_SPIN_CAP) { (void)xb_add(&(bar)[XB_TMO], 1u); break; } } } } while (0)

struct XcdBarrier {
    bool lead; unsigned* bar; unsigned x;
    volatile LAS unsigned* st;
};

__device__ __forceinline__ XcdBarrier xcd_barrier_post(unsigned* bar, volatile LAS unsigned* st) {
    XcdBarrier b; b.bar = bar; b.x = xb_xcc_id(); b.st = st;
    if (threadIdx.x == 0) (void)xb_add(&bar[XB_XCNT(b.x)], 1u);
    return b;
}
__device__ __forceinline__ void xcd_barrier_complete(unsigned* bar, unsigned x, unsigned& nloc, unsigned& nx) {
    const unsigned G = gridDim.x * gridDim.y * gridDim.z;
    unsigned sum, cnt, mine, sp = 0u;
    for (;;) {
        sum = 0u; cnt = 0u; mine = 0u;
#pragma unroll
        for (unsigned j = 0; j < 16; ++j) { const unsigned c = xb_ld(&bar[XB_XCNT(j)]); sum += c; cnt += (c > 0u) ? 1u : 0u; mine = (j == x) ? c : mine; }
        if (sum == G) break;
        __builtin_amdgcn_s_sleep(1);
        if ((++sp & 255u) == 0u) { if (xb_ld(&bar[XB_TMO])) break; if (sp > XB_SPIN_CAP) { (void)xb_add(&bar[XB_TMO], 1u); break; } }
    }
    nloc = mine > 0u ? mine : 1u; nx = cnt > 0u ? cnt : 1u;
}

__device__ __forceinline__ void xcd_barrier(const XcdBarrier& b) {
    asm volatile("s_waitcnt vmcnt(0)" ::: "memory");
    __syncthreads();
    if (b.lead) {
        unsigned* bar = b.bar;
        __builtin_amdgcn_s_waitcnt(0);
        unsigned nloc = b.st[0], nx = b.st[1];
        if (nloc == 0u) { xcd_barrier_complete(bar, b.x, nloc, nx); b.st[0] = nloc; b.st[1] = nx; }
        const unsigned old = xb_add(&bar[XB_XSUB(b.x)], 1u);
        const unsigned gen = old / nloc;
        if (old + 1u == (gen + 1u) * nloc) {
            __builtin_amdgcn_fence(__ATOMIC_RELEASE, "agent");
            asm volatile("s_waitcnt vmcnt(0)" ::: "memory");
            const unsigned og = xb_add(&bar[XB_TOP], 1u);
            const unsigned tg = og / nx;
            if (og + 1u == (tg + 1u) * nx) xb_add(&bar[XB_TOPGEN], 1u);
            else XB_SPIN(xb_ld(&bar[XB_TOPGEN]) == tg, bar);
            __builtin_amdgcn_fence(__ATOMIC_ACQUIRE, "agent");
            xb_add(&bar[XB_XGEN(b.x)], 1u);
            asm volatile("s_waitcnt vmcnt(0)" ::: "memory");
        } else {
            XB_SPIN(xb_ld(&bar[XB_XGEN(b.x)]) == gen, bar);
            __builtin_amdgcn_fence(__ATOMIC_ACQUIRE, "agent");
            asm volatile("s_waitcnt vmcnt(0)" ::: "memory");
        }
    }
    __syncthreads();
}


typedef float f32x16 __attribute__((ext_vector_type(16)));
typedef short v4i16_t __attribute__((ext_vector_type(4)));
typedef float f32x2_t __attribute__((ext_vector_type(2)));
typedef __bf16 bf16x2_t __attribute__((ext_vector_type(2)));
typedef unsigned u32x2 __attribute__((ext_vector_type(2)));
__device__ __forceinline__ unsigned cvtpk(float lo, float hi) { f32x2_t v = {lo, hi}; bf16x2_t b = __builtin_convertvector(v, bf16x2_t); return __builtin_bit_cast(unsigned, b); }
__device__ __forceinline__ int mk_tid(int wv0) { unsigned ones = ~0u; asm volatile("" : "+s"(ones));
    return wv0 * 64 + (int)__builtin_amdgcn_mbcnt_hi(ones, __builtin_amdgcn_mbcnt_lo(ones, 0u)); }
__device__ __forceinline__ float opq(float x) { asm volatile("" : "+v"(x)); return x; }
__device__ __forceinline__ float bf2f(bf16 h) { return __builtin_bit_cast(float, (unsigned)h << 16); }
template <int MASK> __device__ __forceinline__ float xor_f(float v) { return __builtin_bit_cast(float, __builtin_amdgcn_ds_swizzle(__builtin_bit_cast(int, v), (MASK << 10) | 0x1f)); }
__device__ __forceinline__ void swap32(float v, float& lo, float& hi) { unsigned a = __builtin_bit_cast(unsigned, v), b = a; asm volatile("" : "+v"(b)); const auto r = __builtin_amdgcn_permlane32_swap(a, b, false, false);
    unsigned r0 = r[0], r1 = r[1]; asm volatile("" : "+v"(r0), "+v"(r1)); lo = __builtin_bit_cast(float, r0); hi = __builtin_bit_cast(float, r1); }
__device__ __forceinline__ float sum32(float v) { float a, b; swap32(v, a, b); return a + b; }
__device__ __forceinline__ float max32(float v) { float a, b; swap32(v, a, b); return fmaxf(a, b); }
__device__ __forceinline__ float wave_sum(float v) {
    v += xor_f<1>(v); v += xor_f<2>(v); v += xor_f<4>(v); v += xor_f<8>(v); v += xor_f<16>(v);
    return sum32(v);
}

struct Args { const float* in[25]; float* out; unsigned char* ws; int ph_lo, ph_hi; };
struct Frame {
    LAS unsigned char* lds;
    gu32* ctl;
    int tid, lane, wave, vcu, G, wv0;
    const Args* a;
    float* out;
    unsigned char* ws;
};
enum { I_X = 0, I_NORM_MIX, I_W_IN, I_B_GATE, I_LQ1, I_LK1, I_LQ2, I_LK2, I_SUBLN, I_CONV_W, I_CONV_B, I_WA, I_BA, I_WX, I_BX, I_LAMBDA, I_FOX_B, I_SINKS, I_W_BRANCH, I_W_OUT, I_NORM_FFN, I_W_GATE, I_W_UP, I_W_DOWN, I_NORM_FINAL };

struct CDesc { const float* src; unsigned char* dst; int ldsrc, scol4, lddst, drow0, dcol0, f8; };
constexpr int I_IN = 32 * 408, I_BR = 2048, I_OUT = 2048, I_G = 32 * 176, I_D = 88 * 64, PER_LAYER = I_IN + I_BR + I_OUT + 2 * I_G + I_D;
static_assert(I_IN % 128 == 0 && (PER_LAYER - I_IN) % 128 == 0, "weight blocks are dealt 128 at a time");
__device__ __forceinline__ CDesc conv_desc(Frame& F, int l, int r) {
    CDesc d; d.f8 = 0;
    unsigned char* wl = F.ws + WS_W + (size_t)l * W_LAYER;
    const int g4 = 4 * (F.lane & 7);
    if (r < I_IN) { const int kb = r / 408, nb = r % 408, n0 = 32 * nb;
        d.src = F.a->in[I_W_IN] + ((size_t)l * DM + 64 * kb) * IN_COLS; d.ldsrc = IN_COLS; d.lddst = DM; d.dcol0 = 64 * kb;
        if (n0 < 4864) { d.scol4 = (n0 < 4096 ? n0 : n0 + 4) + g4; d.dst = wl + WO_IN; d.drow0 = n0; }
        else { const int q = n0 - 4864, pnp = q >> 8, cl = (q & 255) + g4;
            d.scol4 = 4868 + (2 * (cl >> 7) + ((cl >> 2) & 1)) * 2048 + 64 * pnp + 16 * ((cl >> 5) & 3) + 4 * ((cl >> 3) & 3);
            d.dst = F.ws + WS_W8 + (size_t)l * (16 * MiB); d.drow0 = n0 - 4864; d.f8 = 1; }
        return d; }
    r -= I_IN;
    if (r < I_BR) { const int nbr = r / 512, q = r % 512, kb = q / 64, nb = q % 64;
        d.src = F.a->in[I_W_BRANCH] + (((size_t)l * 4 + nbr) * 512 + 64 * kb) * DM; d.ldsrc = DM; d.scol4 = 32 * nb + g4; d.dst = wl + WO_BR; d.lddst = DM; d.drow0 = 32 * nb; d.dcol0 = 512 * nbr + 64 * kb; return d; }
    r -= I_BR;
    if (r < I_OUT) { const int kb = r / 64, nb = r % 64;
        d.src = F.a->in[I_W_OUT] + ((size_t)l * DM + 64 * kb) * DM; d.ldsrc = DM; d.scol4 = 32 * nb + g4; d.dst = wl + WO_OUT; d.lddst = DM; d.drow0 = 32 * nb; d.dcol0 = 64 * kb; return d; }
    r -= I_OUT;
    if (r < 2 * I_G) { const int up = r / I_G, q = r % I_G, kb = q / 176, nb = q % 176, n0 = 32 * nb;
        d.src = F.a->in[up ? I_W_UP : I_W_GATE] + ((size_t)l * DM + 64 * kb) * DFF; d.ldsrc = DFF; d.scol4 = n0 + g4; d.dst = wl + WO_GU; d.lddst = DM; d.drow0 = (n0 >> 7) * 256 + (n0 & 127) + 128 * up; d.dcol0 = 64 * kb; return d; }
    r -= 2 * I_G;
    { const int kb = r / 64, nb = r % 64;
        d.src = F.a->in[I_W_DOWN] + ((size_t)l * DFF + 64 * kb) * DM; d.ldsrc = DM; d.scol4 = 32 * nb + g4; d.dst = wl + WO_DN; d.lddst = DFF; d.drow0 = 32 * nb; d.dcol0 = 64 * kb; }
    return d;
}
__device__ __forceinline__ size_t img_off(int n, int k, int nkt) {
    const int rr = n & 127, x = rr & 31, R = (rr & ~31) + 16 * ((x >> 2) & 1) + 4 * (x >> 3) + (x & 3);
    return ((((size_t)(n >> 8) * nkt + (k >> 6)) * 2 + ((n >> 7) & 1)) << 14) + (size_t)pg8::lds_byte(R, k & 63);
}
__device__ __forceinline__ void conv_load(const CDesc& d, f32x4 (&v)[8], int lane) {
#pragma unroll
    for (int i = 0; i < 8; ++i) v[i] = *(const f32x4*)(d.src + (size_t)(8 * i + (lane >> 3)) * d.ldsrc + d.scol4);
}
__device__ __forceinline__ void conv_store(const CDesc& d, const f32x4 (&v)[8], LAS float* scr, int lane) {
    const float sc = d.f8 ? FP8_SW : 1.f, lim = d.f8 ? 448.f : 3.0e38f;
#pragma unroll
    for (int i = 0; i < 8; ++i) { LAS float* p = scr + (8 * i + (lane >> 3)) * 33 + 4 * (lane & 7);
#pragma unroll
        for (int e = 0; e < 4; ++e) p[e] = fminf(fmaxf(v[i][e] * sc, -lim), lim); }
    LDS_WAIT(); asm volatile("" ::: "memory");
    const int c = lane & 7;
#pragma unroll
    for (int j = 0; j < 4; ++j) { const int n = (lane >> 3) + 8 * j; const LAS float* s = scr + (8 * c) * 33 + n;
        if (d.f8) {
            int lo = 0, hi = 0;
            lo = __builtin_amdgcn_cvt_pk_fp8_f32(s[0 * 33], s[1 * 33], lo, false); lo = __builtin_amdgcn_cvt_pk_fp8_f32(s[2 * 33], s[3 * 33], lo, true);
            hi = __builtin_amdgcn_cvt_pk_fp8_f32(s[4 * 33], s[5 * 33], hi, false); hi = __builtin_amdgcn_cvt_pk_fp8_f32(s[6 * 33], s[7 * 33], hi, true);
            u32x2 o; o.x = (unsigned)lo; o.y = (unsigned)hi;
            *(GAS u32x2*)(d.dst + img_off(d.drow0 + n, (d.dcol0 + 8 * c) >> 1, d.lddst >> 7)) = o;
        } else {
            v4u o; o.x = cvtpk(s[0 * 33], s[1 * 33]); o.y = cvtpk(s[2 * 33], s[3 * 33]); o.z = cvtpk(s[4 * 33], s[5 * 33]); o.w = cvtpk(s[6 * 33], s[7 * 33]);
            *(GAS v4u*)(d.dst + img_off(d.drow0 + n, d.dcol0 + 8 * c, d.lddst >> 6)) = o; } }
    LDS_WAIT(); asm volatile("" ::: "memory");
}
__device__ __forceinline__ void conv_run(Frame& F, int l, int r0, int step, int nblk, LAS float* scr) {
    f32x4 va[8], vb[8];
    { const CDesc d = conv_desc(F, l, r0); conv_load(d, va, F.lane); }
#pragma unroll 1
    for (int i = 0; i < nblk; i += 2) {
        if (i + 1 < nblk) { const CDesc d = conv_desc(F, l, r0 + (i + 1) * step); conv_load(d, vb, F.lane); }
        { int r = r0 + i * step; asm volatile("" : "+s"(r)); const CDesc d = conv_desc(F, l, r); conv_store(d, va, scr, F.lane); }
        if (i + 2 < nblk) { const CDesc d = conv_desc(F, l, r0 + (i + 2) * step); conv_load(d, va, F.lane); }
        if (i + 1 < nblk) { int r = r0 + (i + 1) * step; asm volatile("" : "+s"(r)); const CDesc d = conv_desc(F, l, r); conv_store(d, vb, scr, F.lane); }
    }
}
__device__ __forceinline__ void p0_weights(Frame& F) {
    LAS float* scr = (LAS float*)(F.lds + RING_OFF + F.wave * 16384);
    const int gw = F.vcu * NWAVES + F.wave, NGW = F.G * NWAVES;
    if (gw < I_IN) conv_run(F, 0, gw, NGW, (I_IN - gw + NGW - 1) / NGW, scr);
    for (int i = (F.vcu * NTHREADS + F.tid); i < DEPTH * 512; i += F.G * NTHREADS) { const float lm = F.a->in[I_LAMBDA][i]; ((float*)(F.ws + WS_LRUK))[i] = -8.0f * (fmaxf(-lm, 0.f) + log1pf(__expf(-fabsf(lm)))); }
    float* wcf = (float*)(F.ws + WS_WCF);
    for (int i = (F.vcu * NTHREADS + F.tid); i < DEPTH * DM; i += F.G * NTHREADS) { const int l = i / DM, k = i % DM;
        const float* w = F.a->in[I_W_IN] + ((size_t)l * DM + k) * IN_COLS + 4096;
        f32x4 o; o.x = w[0]; o.y = w[1]; o.z = w[2]; o.w = w[3]; *(f32x4*)(wcf + 4 * (size_t)i) = o; }
}

template <int MODE, bool SRC16> __device__ __forceinline__ void norm_phase(Frame& F, const void* srcv, const float* gain, bf16* U, float* outf, int layer) {
    LAS float* red = (LAS float*)(F.lds + RING_OFF);
    const int w = F.wave, fr = F.lane & 15, fq = F.lane >> 4;
    int par = 0;
    for (int rg = F.vcu; rg < M / 16; rg += F.G, par ^= 1) {
        const int m = 16 * rg + fr;
        f32x4 v[8][2]; float ss = 0.f;
#pragma unroll
        for (int i = 0; i < 8; ++i) { const int c0 = 64 * (4 * w + (i >> 1)) + 32 * (i & 1) + 8 * fq;
            if (SRC16) { const v4u q = *(const v4u*)((const char*)srcv + pg8::img_a(m, c0, 32));
                v[i][0] = (f32x4){__builtin_bit_cast(float, q.x << 16), __builtin_bit_cast(float, q.x & 0xffff0000u), __builtin_bit_cast(float, q.y << 16), __builtin_bit_cast(float, q.y & 0xffff0000u)};
                v[i][1] = (f32x4){__builtin_bit_cast(float, q.z << 16), __builtin_bit_cast(float, q.z & 0xffff0000u), __builtin_bit_cast(float, q.w << 16), __builtin_bit_cast(float, q.w & 0xffff0000u)};
            } else { const float* xr = (const float*)srcv + (size_t)m * DM + c0; v[i][0] = *(const f32x4*)xr; v[i][1] = *(const f32x4*)(xr + 4); } }
#pragma unroll
        for (int i = 0; i < 8; ++i)
#pragma unroll
            for (int h = 0; h < 2; ++h) ss += (v[i][h].x * v[i][h].x + v[i][h].y * v[i][h].y) + (v[i][h].z * v[i][h].z + v[i][h].w * v[i][h].w);
        ss += xor_f<16>(ss); ss = sum32(ss);
        if (fq == 0) red[(par * 8 + w) * 16 + fr] = ss;
        __syncthreads();
        float tot = 0.f;
#pragma unroll
        for (int ww = 0; ww < 8; ++ww) tot += red[(par * 8 + ww) * 16 + fr];
        const float rstd = rsqrtf(tot * (1.f / DM) + RMS_EPS);
        float c0_ = 0.f, c1_ = 0.f, c2_ = 0.f, c3_ = 0.f;
#pragma unroll
        for (int i = 0; i < 8; ++i) { const int c0 = 64 * (4 * w + (i >> 1)) + 32 * (i & 1) + 8 * fq;
            const f32x4 g0 = *(const f32x4*)(gain + c0), g1 = *(const f32x4*)(gain + c0 + 4);
            const f32x4 u0 = v[i][0] * rstd * g0, u1 = v[i][1] * rstd * g1;
            if (MODE == 2) { float* orow = outf + (size_t)m * DM + c0; *(f32x4*)orow = u0; *(f32x4*)(orow + 4) = u1; }
            else {
                v4u o; o.x = cvtpk(u0.x, u0.y); o.y = cvtpk(u0.z, u0.w); o.z = cvtpk(u1.x, u1.y); o.w = cvtpk(u1.z, u1.w);
                *(v4u*)((char*)U + pg8::img_a(m, c0, 32)) = o;
                if (MODE == 1) {
                    const f32x4 lo4 = {-448.f, -448.f, -448.f, -448.f}, hi4 = {448.f, 448.f, 448.f, 448.f};
                    const f32x4 q0 = __builtin_elementwise_min(__builtin_elementwise_max(u0 * FP8_SA, lo4), hi4), q1 = __builtin_elementwise_min(__builtin_elementwise_max(u1 * FP8_SA, lo4), hi4);
                    int wa = 0, wb = 0; wa = __builtin_amdgcn_cvt_pk_fp8_f32(q0.x, q0.y, wa, false); wa = __builtin_amdgcn_cvt_pk_fp8_f32(q0.z, q0.w, wa, true);
                    wb = __builtin_amdgcn_cvt_pk_fp8_f32(q1.x, q1.y, wb, false); wb = __builtin_amdgcn_cvt_pk_fp8_f32(q1.z, q1.w, wb, true);
                    u32x2 o8; o8.x = (unsigned)wa; o8.y = (unsigned)wb;
                    *(u32x2*)(F.ws + WS_U8 + pg8::img_a(m, c0 >> 1, 16)) = o8;
                    const float* wc = (const float*)(F.ws + WS_WCF) + ((size_t)layer * DM + c0) * 4;
#pragma unroll
                    for (int e = 0; e < 8; ++e) { const f32x4 wv_ = *(const f32x4*)(wc + 4 * e); const float u = (e < 4) ? u0[e & 3] : u1[e & 3];
                        c0_ += u * wv_.x; c1_ += u * wv_.y; c2_ += u * wv_.z; c3_ += u * wv_.w; }
                }
            }
        }
        if (MODE == 1) {
            c0_ += xor_f<16>(c0_); c0_ = sum32(c0_); c1_ += xor_f<16>(c1_); c1_ = sum32(c1_); c2_ += xor_f<16>(c2_); c2_ = sum32(c2_); c3_ += xor_f<16>(c3_); c3_ = sum32(c3_);
            LAS float* dots = red + 256 + (par * 8 + w) * 64;
            if (fq == 0) { f32x4 o = {c0_, c1_, c2_, c3_}; *(LAS f32x4*)(dots + 4 * fr) = o; }
            __syncthreads();
            if (w == 0 && fq == 0) { f32x4 acc = {0.f, 0.f, 0.f, 0.f};
#pragma unroll
                for (int ww = 0; ww < 8; ++ww) acc += *(const LAS f32x4*)(red + 256 + (par * 8 + ww) * 64 + 4 * fr);
                const float* fb = F.a->in[I_FOX_B] + 4 * layer; f32x4 o;
#pragma unroll
                for (int e = 0; e < 4; ++e) { const float x = acc[e] + fb[e]; o[e] = fminf(x, 0.f) - __logf(1.0f + __expf(-fabsf(x))); }
                *(f32x4*)((float*)(F.ws + WS_LOGF) + 4 * (size_t)m) = o; }
        }
    }
    __syncthreads();
}


__device__ __forceinline__ unsigned off_b(unsigned row, unsigned ch) { return 256u * row + 16u * (ch ^ (((row & 3u) << 2) | ((row >> 2) & 3u))); }
__device__ __forceinline__ v4i16_t tr_read(const LAS unsigned char* p) { return __builtin_amdgcn_ds_read_tr16_b64_v4i16((LAS v4i16_t*)p); }

#ifndef DBG_X
#define DBG_X 0
#endif
template <int NS, int NC, bool WINDOW>
__device__ __forceinline__ void attn_pass(LAS unsigned char* L, const bf16* __restrict__ Kg, const bf16* __restrict__ Vg, const bf16* __restrict__ Qlane, const int s0, const int c0,
                                          const int t_lo, const int t_hi, const int qpos, const int wq_min, const int wq_max, const int bias_k0, const float C2,
                                          f32x16 (&o)[NC], float& l_run, const int tid0) {
    int tid_ = tid0; asm volatile("" : "+v"(tid_));
    const int tid = tid_, lane = tid & 63, hi = lane >> 5, l31 = lane & 31;
    bf16x8 qf[NS];
#pragma unroll
    for (int s = 0; s < NS; ++s) qf[s] = *(const bf16x8*)(Qlane + 16 * s + 8 * hi);
#pragma unroll
    for (int c = 0; c < NC; ++c)
#pragma unroll
        for (int r = 0; r < 16; ++r) o[c][r] = 0.f;
    l_run = 0.f;
    const int wv = __builtin_amdgcn_readfirstlane(tid >> 6);
    const int srow = 4 * wv + (lane >> 4);
    const int sch = (lane & 15) ^ (((srow & 3) << 2) | ((srow >> 2) & 3));
    const bf16* kgp = Kg + (size_t)srow * ZP + sch * 8;
    const bf16* vgp = Vg + (size_t)srow * ZP + sch * 8;
#define MX_DMA(t_, buf_) do { const size_t g_ = (size_t)(t_) * 64 * ZP; const int lb_ = (buf_) * 16384 + wv * 1024; \
        __builtin_amdgcn_global_load_lds((const unsigned*)(kgp + g_), (LAS unsigned*)(L + MX_KIMG + lb_), 16, 0, 0); \
        __builtin_amdgcn_global_load_lds((const unsigned*)(kgp + g_ + (size_t)32 * ZP), (LAS unsigned*)(L + MX_KIMG + lb_ + 8192), 16, 0, 0); \
        __builtin_amdgcn_global_load_lds((const unsigned*)(vgp + g_), (LAS unsigned*)(L + MX_VIMG + lb_), 16, 0, 0); \
        __builtin_amdgcn_global_load_lds((const unsigned*)(vgp + g_ + (size_t)32 * ZP), (LAS unsigned*)(L + MX_VIMG + lb_ + 8192), 16, 0, 0); } while (0)
    const unsigned xr = ((unsigned)(l31 & 3) << 2) | ((unsigned)(l31 >> 2) & 3u);
    const unsigned krow = 256u * (unsigned)l31;
    const unsigned blk = (lane >> 4) & 1, q4 = (lane & 15) >> 2, p = lane & 3;
    const unsigned trb0 = 256u * (4u * hi + q4) + 8u * (p & 1), trb1 = trb0 + 2048u;
    const unsigned xt0 = (q4 << 2) | ((unsigned)hi & 3u), xt1 = (q4 << 2) | (((unsigned)hi + 2u) & 3u);
    const unsigned cl = 2u * blk + (p >> 1);
    const int NT = t_hi - t_lo;
    MX_DMA(t_hi - 1, 0);
    if (NT > 1) MX_DMA(t_hi - 2, 1);
    asm volatile("s_waitcnt vmcnt(0) lgkmcnt(0)\n\ts_barrier" ::: "memory");
    const float sinit = -((const LAS float*)(L + MX_BIAS))[wq_max - bias_k0] / C2;
    for (int i = 0; i < NT; ++i) {
        const int t = t_hi - 1 - i, buf = i & 3;
        if (!(i & 1)) { if (i + 2 < NT) MX_DMA(t - 2, (i + 2) & 3); if (i + 3 < NT) MX_DMA(t - 3, (i + 3) & 3); }
        const int k0 = 64 * t;
        const bool skip = (k0 > wq_max) || (WINDOW && (k0 + 63 < wq_min - 127));
        if (!skip) {
            const LAS unsigned char* Kb = L + MX_KIMG + buf * 16384;
            const LAS unsigned char* Vb = L + MX_VIMG + buf * 16384;
            f32x16 sa[2];
            unsigned xr_ = xr, krow_ = krow; asm volatile("" : "+v"(xr_), "+v"(krow_));
            for (int xq = 0; xq < (DBG_X == 2 ? 2 : 1); ++xq) {
            if (xq) asm volatile("" : "+v"(sa[0]), "+v"(sa[1]));
#pragma unroll
            for (int r = 0; r < 16; ++r) { sa[0][r] = sinit; sa[1][r] = sinit; }
            constexpr int GS = (NS == 8) ? 2 : 4;
#pragma unroll
            for (int sg = 0; sg < NS; sg += GS) {
                bf16x8 kf[2][GS];
#pragma unroll
                for (int s = 0; s < GS; ++s) { const unsigned ch = (unsigned)(2 * (s0 + sg + s) + hi);
#pragma unroll
                    for (int b = 0; b < 2; ++b) kf[b][s] = *(const LAS bf16x8*)(Kb + b * 8192 + krow_ + 16u * (ch ^ xr_)); }
#pragma unroll
                for (int s = 0; s < GS; ++s)
#pragma unroll
                    for (int b = 0; b < 2; ++b) sa[b] = __builtin_amdgcn_mfma_f32_32x32x16_bf16(kf[b][s], qf[sg + s], sa[b], 0, 0, 0);
            }
            }
            const LAS float* bl = (const LAS float*)(L + MX_BIAS) + (k0 - bias_k0) + 4 * hi;
#pragma unroll
            for (int b = 0; b < 2; ++b)
#pragma unroll
                for (int rr = 0; rr < 4; ++rr) { const f32x4 bv = *(const LAS f32x4*)(bl + 32 * b + 8 * rr);
#pragma unroll
                    for (int e = 0; e < 4; ++e) sa[b][4 * rr + e] = __builtin_fmaf(sa[b][4 * rr + e], C2, bv[e]); }
            const bool need_mask = (k0 + 63 > wq_min) || (WINDOW && (k0 < wq_max - 127));
            if (need_mask) {
#pragma unroll
                for (int b = 0; b < 2; ++b)
#pragma unroll
                    for (int r = 0; r < 16; ++r) { const int kpos = k0 + 32 * b + (r & 3) + 8 * (r >> 2) + 4 * hi;
                        const bool bad = (kpos > qpos) || (WINDOW && (qpos - kpos >= 128));
                        sa[b][r] = bad ? NEGBIG : sa[b][r]; }
            }
            float mt = sa[0][0];
#pragma unroll
            for (int r = 1; r < 16; ++r) mt = fmaxf(mt, sa[0][r]);
#pragma unroll
            for (int r = 0; r < 16; ++r) mt = fmaxf(mt, sa[1][r]);
            if (__any(mt > 120.f)) {
#pragma unroll
                for (int b = 0; b < 2; ++b)
#pragma unroll
                    for (int r = 0; r < 16; ++r) sa[b][r] = fminf(sa[b][r], 120.f);
            }
            if (!__all(mt < -150.f)) {
            if (DBG_X == 3) { float du = 0.f;
#pragma unroll
                for (int b = 0; b < 2; ++b)
#pragma unroll
                    for (int r = 0; r < 16; ++r) du += __builtin_amdgcn_exp2f(sa[b][r] * 0.999f);
                asm volatile("" :: "v"(du)); }
            float ls = 0.f;
#pragma unroll
            for (int b = 0; b < 2; ++b)
#pragma unroll
                for (int r = 0; r < 16; ++r) { const float pv = __builtin_amdgcn_exp2f(sa[b][r]); sa[b][r] = pv; ls += pv; }
            l_run += ls;
            bf16x8 pf[4];
#pragma unroll
            for (int ks = 0; ks < 4; ++ks) { const int b = ks >> 1, r0 = 8 * (ks & 1);
                v4u w; w.x = cvtpk(sa[b][r0 + 0], sa[b][r0 + 1]); w.y = cvtpk(sa[b][r0 + 2], sa[b][r0 + 3]); w.z = cvtpk(sa[b][r0 + 4], sa[b][r0 + 5]); w.w = cvtpk(sa[b][r0 + 6], sa[b][r0 + 7]);
                pf[ks] = __builtin_bit_cast(bf16x8, w); }
            unsigned tb0_ = trb0, tb1_ = trb1, x0_ = xt0, x1_ = xt1, cl_ = cl; asm volatile("" : "+v"(tb0_), "+v"(tb1_), "+v"(x0_), "+v"(x1_), "+v"(cl_));
#pragma unroll
            for (int c = 0; c < NC; ++c) {
                const unsigned chb = 4u * (unsigned)(c0 + c) + cl_; const unsigned a0 = tb0_ + 16u * (chb ^ x0_), a1 = tb1_ + 16u * (chb ^ x1_);
                v4i16_t vlo[4], vhi[4];
#pragma unroll
                for (int ks = 0; ks < 4; ++ks) { vlo[ks] = tr_read(Vb + ks * 4096 + a0); vhi[ks] = tr_read(Vb + ks * 4096 + a1); }
#pragma unroll
                for (int ks = 0; ks < 4; ++ks) { const v4i16_t lo = vlo[ks], hv = vhi[ks];
                    const bf16x8 vf = (bf16x8){lo[0], lo[1], lo[2], lo[3], hv[0], hv[1], hv[2], hv[3]};
                    o[c] = __builtin_amdgcn_mfma_f32_32x32x16_bf16(vf, pf[ks], o[c], 0, 0, 0); }
            }
            }
        }
        if ((i & 1) || i + 1 == NT) asm volatile("s_waitcnt vmcnt(0) lgkmcnt(0)\n\ts_barrier" ::: "memory");
    }
#undef MX_DMA
}

template <int NC> __device__ __forceinline__ void store_o(bf16* Y, size_t grow, int colbase, int hi, const f32x16 (&o)[NC]) {
    const int ycol = colbase + 8 * (1 - hi);
#pragma unroll
    for (int c = 0; c < NC; ++c)
#pragma unroll
        for (int j = 0; j < 2; ++j) {
            const int ra = 8 * j, rb_ = 8 * j + 4;
            const auto r0 = __builtin_amdgcn_permlane32_swap(cvtpk(o[c][rb_ + 0], o[c][rb_ + 1]), cvtpk(o[c][ra + 0], o[c][ra + 1]), false, false);
            const auto r1 = __builtin_amdgcn_permlane32_swap(cvtpk(o[c][rb_ + 2], o[c][rb_ + 3]), cvtpk(o[c][ra + 2], o[c][ra + 3]), false, false);
            v4u v; v.x = r0[0]; v.y = r1[0]; v.z = r0[1]; v.w = r1[1];
            *(v4u*)((char*)Y + pg8::img_a((int)grow, ycol + 32 * c + 16 * j, 32)) = v; }
}


__device__ __forceinline__ float wave_max(float v) {
    v = max32(v); v = fmaxf(v, xor_f<16>(v)); v = fmaxf(v, xor_f<8>(v)); v = fmaxf(v, xor_f<4>(v)); v = fmaxf(v, xor_f<2>(v)); v = fmaxf(v, xor_f<1>(v));
    return v;
}
template <int NS>
__device__ __forceinline__ float q_norm2(const bf16* __restrict__ Qlane, int hi) {
    float ss = 0.f;
#pragma unroll
    for (int s = 0; s < NS; ++s) { const bf16x8 v = *(const bf16x8*)(Qlane + 16 * s + 8 * hi);
#pragma unroll
        for (int e = 0; e < 8; ++e) { const float f = bf2f((bf16)v[e]); ss += f * f; } }
    return sum32(ss);
}
template <int NM>
__device__ __forceinline__ int horizon(Frame& F, LAS unsigned char* L, const gu64* gran, int NTt, int ref_row, float C2, float qn2) {
    LAS float* scr = (LAS float*)(L + MX_SCR);
    const float wm = wave_max(qn2);
    if (F.lane == 0) scr[16 + F.wave] = wm;
    __syncthreads();
    if (F.wave == 0) {
        const LAS float* bias = (const LAS float*)(L + MX_BIAS);
        const int tt = F.lane;
        bool ok = tt < NTt;
        if (ok) {
            const float bd = bias[64 * tt + 63] - bias[ref_row];
#pragma unroll
            for (int m = 0; m < NM; ++m) {
                float q2 = 0.f;
#pragma unroll
                for (int w = 0; w < 8 / NM; ++w) q2 = fmaxf(q2, scr[16 + (8 / NM) * m + w]);
                unsigned long long g; unsigned spins = 0;
                for (;;) { g = __hip_atomic_load(gran + 64 * m + tt, RLX_AGENT); if ((g >> 32) == 1ull) break; __builtin_amdgcn_s_sleep(2); if (++spins > (1u << 16)) break; }
                const float kmax = __builtin_bit_cast(float, (unsigned)g);
                ok = ok && ((g >> 32) == 1ull) && (1.01f * C2 * __builtin_amdgcn_sqrtf(q2) * kmax + bd < -152.f);
            }
        }
        const unsigned long long mask = __ballot(ok);
        int ts = (~mask == 0ull) ? 64 : (int)__builtin_ctzll(~mask);
        if (ts > NTt - 1) ts = NTt - 1;
        if (F.lane == 0) ((LAS int*)scr)[32] = ts;
    }
    __syncthreads();
    return __builtin_amdgcn_readfirstlane(((LAS int*)scr)[32]);
}

__device__ __forceinline__ void unit_A(Frame& F, int layer, int b, int h, int qb) {
    LAS unsigned char* L = F.lds + RING_OFF;
    const bf16* Z = (const bf16*)(F.ws + WS_Z);
    const int hi = F.lane >> 5, l31 = F.lane & 31, q0 = 128 * qb, map = F.wave >> 2, wq_min = q0 + 32 * (F.wave & 3), qpos = wq_min + l31;
    const size_t rb = (size_t)b * SEQ;
    const float L2E = opq(LOG2E);
    const float slope2 = exp2f(-2.0f * (float)(h + 1)) * L2E;
    LAS float* bias = (LAS float*)(L + MX_BIAS);
    const int nkeys = q0 + 128;
    for (int i = F.tid; i < nkeys; i += NTHREADS) bias[i] = slope2 * (float)(i - (q0 + 127));
    const bf16* Kg = Z + rb * ZP + ZC_AK + 128 * h; const bf16* Vg = Z + rb * ZP + ZC_AV + 128 * h;
    const bf16* Ql = Z + (rb + qpos) * ZP + ZC_AQ + 128 * h + 64 * map;
    const float C2 = 0.125f * L2E;
    f32x16 o[4]; float l;
    int t_stop = 0;
    if (h < 2) t_stop = horizon<2>(F, L, (const gu64*)(F.ws + WS_KMAX) + (size_t)(((layer * 4 + b) * 12 + 2 * h) * 64), nkeys / 64, q0 + 31, C2, q_norm2<4>(Ql, hi));
    attn_pass<4, 4, false>(L, Kg, Vg, Ql, 4 * map, 0, t_stop, nkeys / 64, qpos, wq_min, wq_min + 31, 0, C2, o, l, F.tid);
    l = sum32(l);
    int t2 = mk_tid(F.wv0); asm volatile("" : "+v"(t2));
    const int lane2 = t2 & 63, wave2 = __builtin_amdgcn_readfirstlane(t2 >> 6), hi2 = lane2 >> 5, qpos2 = 128 * qb + 32 * (wave2 & 3) + (lane2 & 31);
    int ly = layer; asm volatile("" : "+s"(ly));
    const float lam_init = 0.8f - 0.6f * __expf(-0.3f * (float)ly);
    LAS f32x4* xch = (LAS f32x4*)(L + MX_KIMG) + (size_t)((wave2 & 3) * 16) * 64 + lane2;
    if (wave2 >= 4) {
        float lam;
        {   const float* lq1 = F.a->in[I_LQ1] + 64 * layer; const float* lk1 = F.a->in[I_LK1] + 64 * layer; const float* lq2 = F.a->in[I_LQ2] + 64 * layer; const float* lk2 = F.a->in[I_LK2] + 64 * layer;
            const float s1 = wave_sum(lq1[lane2] * lk1[lane2]), s2 = wave_sum(lq2[lane2] * lk2[lane2]);
            lam = __expf(s1) - __expf(s2) + lam_init; }
        const float sc = lam / l;
#pragma unroll
        for (int c = 0; c < 4; ++c)
#pragma unroll
            for (int rr = 0; rr < 4; ++rr) { f32x4 v; v.x = o[c][4 * rr] * sc; v.y = o[c][4 * rr + 1] * sc; v.z = o[c][4 * rr + 2] * sc; v.w = o[c][4 * rr + 3] * sc; xch[(4 * c + rr) * 64] = v; }
    }
    __syncthreads();
    if (wave2 < 4) {
        const float inv = 1.0f / l; float ss = 0.f;
#pragma unroll
        for (int c = 0; c < 4; ++c)
#pragma unroll
            for (int rr = 0; rr < 4; ++rr) { const f32x4 v = xch[(4 * c + rr) * 64];
#pragma unroll
                for (int e = 0; e < 4; ++e) { const float d = o[c][4 * rr + e] * inv - v[e]; o[c][4 * rr + e] = d; ss += d * d; } }
        ss = sum32(ss);
        const float rn = rsqrtf(ss * (1.f / 128.f) + RMS_EPS) * (1.f - lam_init);
        const float* sg = F.a->in[I_SUBLN] + 128 * layer + 4 * hi2;
#pragma unroll
        for (int c = 0; c < 4; ++c)
#pragma unroll
            for (int rr = 0; rr < 4; ++rr) { const f32x4 g = *(const f32x4*)(sg + 32 * c + 8 * rr);
#pragma unroll
                for (int e = 0; e < 4; ++e) o[c][4 * rr + e] *= rn * g[e]; }
        store_o<4>((bf16*)(F.ws + WS_Y), (size_t)b * SEQ + qpos2, 128 * h, hi2, o);
    }
    __syncthreads();
}

__device__ __forceinline__ void unit_C(Frame& F, int layer, int b, int h, int qb) {
    LAS unsigned char* L = F.lds + RING_OFF;
    const bf16* Z = (const bf16*)(F.ws + WS_Z); bf16* Y = (bf16*)(F.ws + WS_Y);
    const int hi = F.lane >> 5, l31 = F.lane & 31, q0 = 256 * qb, wq_min = q0 + 32 * F.wave, qpos = wq_min + l31;
    const size_t rb = (size_t)b * SEQ;
    LAS float* bias = (LAS float*)(L + MX_BIAS); LAS float* wtot = (LAS float*)(L + MX_SCR);
    const float L2E = opq(LOG2E);
    const int nkeys = q0 + 256;
    {
        const float* lf = (const float*)(F.ws + WS_LOGF) + rb * 4 + h;
        float v[8]; const int i0 = 8 * F.tid;
#pragma unroll
        for (int e = 0; e < 8; ++e) v[e] = (i0 + e < nkeys) ? lf[(size_t)(i0 + e) * 4] : 0.f;
#pragma unroll
        for (int e = 1; e < 8; ++e) v[e] += v[e - 1];
        float x = v[7];
#pragma unroll
        for (int o = 1; o < 64; o <<= 1) { const float t = __builtin_bit_cast(float, __builtin_amdgcn_ds_bpermute(4 * ((F.lane >= o) ? F.lane - o : F.lane), __builtin_bit_cast(int, x))); if (F.lane >= o) x += t; }
        if (F.lane == 63) wtot[F.wave] = x;
        __syncthreads();
        float woff = 0.f, tot = 0.f;
#pragma unroll
        for (int w = 0; w < NWAVES; ++w) { const float tw = wtot[w]; tot += tw; woff += (w < F.wave) ? tw : 0.f; }
        const float base = woff + (x - v[7]);
#pragma unroll
        for (int e = 0; e < 8; ++e) if (i0 + e < nkeys) bias[i0 + e] = (tot - (base + v[e])) * L2E;
    }
    const bf16* Kg = Z + rb * ZP + ZC_CK + 128 * h; const bf16* Vg = Z + rb * ZP + ZC_CV + 128 * h;
    const bf16* Ql = Z + (rb + qpos) * ZP + ZC_CQ + 128 * h;
    const float C2 = 0.08838834764831845f * L2E;
    f32x16 o[4]; float l;
    const int t_stop = horizon<1>(F, L, (const gu64*)(F.ws + WS_KMAX) + (size_t)(((layer * 4 + b) * 12 + 8 + h) * 64), nkeys / 64, q0 + 31, C2, q_norm2<8>(Ql, hi));
    attn_pass<8, 4, false>(L, Kg, Vg, Ql, 0, 0, t_stop, nkeys / 64, qpos, wq_min, wq_min + 31, 0, C2, o, l, F.tid);
    l = sum32(l);
    {   const float inv = 1.0f / l;
#pragma unroll
        for (int c = 0; c < 4; ++c)
#pragma unroll
            for (int r = 0; r < 16; ++r) o[c][r] *= inv; }
    store_o<4>(Y, rb + qpos, 1024 + 128 * h, hi, o);
}

__device__ __forceinline__ void unit_D(Frame& F, int layer, int b, int kv, int rbk) {
    LAS unsigned char* L = F.lds + RING_OFF;
    const bf16* Z = (const bf16*)(F.ws + WS_Z); bf16* Y = (bf16*)(F.ws + WS_Y);
    const int hi = F.lane >> 5, l31 = F.lane & 31, q0 = 64 * rbk, j = F.wave >> 1, hq = 4 * kv + j, wq_min = q0 + 32 * (F.wave & 1), qpos = wq_min + l31;
    const size_t rb = (size_t)b * SEQ;
    const float L2E = opq(LOG2E);
    LAS float* bias = (LAS float*)(L + MX_BIAS);
    const int k_lo = (q0 >= 128) ? q0 - 128 : 0, nkeys = q0 + 64 - k_lo;
    for (int i = F.tid; i < 1024; i += NTHREADS) { const int jj = i >> 8, ii = i & 255;
        if (ii < nkeys) bias[i] = exp2f(-(float)(4 * kv + jj + 1)) * L2E * (float)(k_lo + ii - (q0 + 63)); }
    const float slope2 = exp2f(-(float)(hq + 1)) * L2E;
    const bf16* Kg = Z + rb * ZP + ZC_DK; const bf16* Vg = Z + rb * ZP + ZC_DV;
    const bf16* Ql = Z + (rb + qpos) * ZP + ZC_DQ + 64 * hq;
    const float C2 = 0.125f * L2E;
    f32x16 o[2]; float l;
    attn_pass<4, 2, true>(L, Kg, Vg, Ql, 4 * kv, 2 * kv, k_lo / 64, (q0 + 64) / 64, qpos, wq_min, wq_min + 31, k_lo - 256 * j, C2, o, l, F.tid);
    l = sum32(l);
    {   const float sink2 = F.a->in[I_SINKS][8 * layer + hq] * L2E;
        const float inv = 1.0f / (l + __builtin_amdgcn_exp2f(sink2 + slope2 * (float)(qpos - (wq_min + 31))));
#pragma unroll
        for (int c = 0; c < 2; ++c)
#pragma unroll
            for (int r = 0; r < 16; ++r) o[c][r] *= inv; }
    store_o<2>(Y, rb + qpos, 1536 + 64 * hq, hi, o);
}

__device__ __forceinline__ void unit_N(Frame& F, int layer, int b, int hm) {
    const bf16* Z = (const bf16*)(F.ws + WS_Z);
    const int col = (hm < 8) ? ZC_AK + 64 * hm : ZC_CK + 128 * (hm - 8);
    const int nh = (hm < 8) ? 1 : 2;
    gu64* gran = (gu64*)(F.ws + WS_KMAX) + (size_t)(((layer * 4 + b) * 12 + hm) * 64);
    unsigned tag1; asm volatile("v_mov_b32 %0, 1" : "=v"(tag1));
#pragma unroll 1
    for (int i = 0; i < 8; ++i) {
        const int tile = 8 * i + F.wave;
        const bf16* kp = Z + ((size_t)b * SEQ + 64 * tile + F.lane) * ZP + col;
        float ss = 0.f;
#pragma unroll 1
        for (int hf = 0; hf < nh; ++hf) {
            bf16x8 v[8];
#pragma unroll
            for (int c = 0; c < 8; ++c) v[c] = *(const bf16x8*)(kp + 64 * hf + 8 * c);
#pragma unroll
            for (int c = 0; c < 8; ++c)
#pragma unroll
                for (int e = 0; e < 8; ++e) { const float f = bf2f((bf16)v[c][e]); ss += f * f; }
        }
        const float m = __builtin_amdgcn_sqrtf(wave_max(ss));
        if (F.lane == 0) __hip_atomic_store(gran + tile, ((unsigned long long)tag1 << 32) | (unsigned long long)__builtin_bit_cast(unsigned, m), RLX_AGENT);
    }
}

constexpr int MXW_A = (PER_LAYER - I_IN) / 128, MXW_B = I_IN / 128;
__device__ __forceinline__ void unit_W(Frame& F, int layer, int j) {
    LAS float* scr = (LAS float*)(F.lds + RING_OFF + F.wave * 16384);
    int l = layer, r0 = I_IN + 128 * j;
    if (j >= MXW_A) { l = layer + 1; r0 = 128 * (j - MXW_A); if (l >= DEPTH || j >= MXW_A + MXW_B) return; }
    conv_run(F, l, r0 + F.wave, 8, 16, scr);
}


__device__ __forceinline__ float neg_expm1(float x) {
    const float p = x * (1.f + x * (0.5f + x * (0.16666667f + x * (0.041666668f + x * (0.008333334f + x * (0.0013888889f + x * (0.0001984127f + x * 0.0000248016f)))))));
    return (x > -0.35f) ? -p : (1.f - __expf(x));
}
__device__ __forceinline__ float gelu_tanh(float x) { const float u = 0.7978845608028654f * (x + 0.044715f * x * x * x); const float t = 1.f - 2.f * __builtin_amdgcn_rcpf(1.f + __expf(2.f * u)); return 0.5f * x * (1.f + t); }
__device__ __forceinline__ void unit_B(Frame& F, int layer, int b, int n, int c) {
    LAS unsigned char* L = F.lds + RING_OFF;
    const bf16* Z = (const bf16*)(F.ws + WS_Z); bf16* Y = (bf16*)(F.ws + WS_Y);
    LAS float* XC = (LAS float*)(L + LR_XC); LAS float* AA = (LAS float*)(L + LR_A); LAS float* UU = (LAS float*)(L + LR_U);
    LAS bf16* WT = (LAS bf16*)(L + LR_WT); LAS float* SEGA = (LAS float*)(L + LR_SEGA); LAS float* SEGH = (LAS float*)(L + LR_SEGH);
    LAS float* CARRY = (LAS float*)(L + LR_CARRY); LAS float* CARRYP = (LAS float*)(L + LR_CARRYP); LAS float* HIN = (LAS float*)(L + LR_HIN);
    const int tid = F.tid, lane = F.lane, wave = F.wave, hi = lane >> 5, l31 = lane & 31;
    const size_t rb = (size_t)b * SEQ;
    const int ch0 = 64 * n;
    {   const float* wa = F.a->in[I_WA] + ((size_t)layer * 8 + n) * 4096; const float* wx = F.a->in[I_WX] + ((size_t)layer * 8 + n) * 4096;
        for (int i = tid; i < 8192; i += NTHREADS) { const int which = i >> 12, q = i & 4095, cc = q >> 6, d = q & 63;
            const float v = which ? wx[q] : wa[q]; WT[(64 * which + d) * 72 + cc] = (bf16)(cvtpk(v, 0.f) & 0xffffu); } }
    if (tid < 64) { CARRY[tid] = 0.f; CARRYP[tid] = 1.f; }
    const int sc = tid & 63, seg = tid >> 6;
    float cw[4];
#pragma unroll
    for (int j = 0; j < 4; ++j) cw[j] = F.a->in[I_CONV_W][((size_t)layer * 4 + j) * 512 + ch0 + sc];
    const float cb = F.a->in[I_CONV_B][layer * 512 + ch0 + sc];
    const int tb = wave >> 1, chh = wave & 1;
    float k_ba[16], k_bx[16], k_sp[16];
#pragma unroll
    for (int r = 0; r < 16; ++r) { const int cc = ch0 + 32 * chh + (r & 3) + 8 * (r >> 2) + 4 * hi;
        k_ba[r] = F.a->in[I_BA][layer * 512 + cc]; k_bx[r] = F.a->in[I_BX][layer * 512 + cc];
        k_sp[r] = ((const float*)(F.ws + WS_LRUK))[layer * 512 + cc]; }
    __syncthreads();
    const bf16* bxp = Z + rb * ZP + ZC_BX + ch0 + sc;
    f32x2_t* hpp = (f32x2_t*)(F.ws + WS_HL) + rb * 512 + ch0 + sc;
    unsigned short xr[19];
#pragma unroll
    for (int j = 0; j < 19; ++j) { const int t = 512 * c + 16 * seg - 3 + j; xr[j] = (t >= 0) ? bxp[(size_t)t * ZP] : (unsigned short)0; }
#pragma unroll
    for (int j = 0; j < 16; ++j) XC[(16 * seg + j) * LR_P + sc] = cb + cw[0] * bf2f(xr[j]) + cw[1] * bf2f(xr[j + 1]) + cw[2] * bf2f(xr[j + 2]) + cw[3] * bf2f(xr[j + 3]);
    for (int tile = 0; tile < 4; ++tile) {
        const int t0 = 512 * c + 128 * tile;
        if (tile < 3) {
#pragma unroll
            for (int j = 0; j < 19; ++j) xr[j] = bxp[(size_t)(t0 + 128 + 16 * seg - 3 + j) * ZP]; }
        __syncthreads();
        {   f32x16 dr, di;
#pragma unroll
            for (int r = 0; r < 16; ++r) { dr[r] = 0.f; di[r] = 0.f; }
            const LAS float* xrow = XC + (32 * tb + l31) * LR_P + 8 * hi;
#pragma unroll
            for (int s = 0; s < 4; ++s) {
                const f32x4 x0 = *(const LAS f32x4*)(xrow + 16 * s), x1 = *(const LAS f32x4*)(xrow + 16 * s + 4);
                v4u xw; xw.x = cvtpk(x0.x, x0.y); xw.y = cvtpk(x0.z, x0.w); xw.z = cvtpk(x1.x, x1.y); xw.w = cvtpk(x1.z, x1.w);
                const bf16x8 xf = __builtin_bit_cast(bf16x8, xw);
                const bf16x8 wr_ = *(const LAS bf16x8*)(WT + (32 * chh + l31) * 72 + 16 * s + 8 * hi);
                const bf16x8 wi_ = *(const LAS bf16x8*)(WT + (64 + 32 * chh + l31) * 72 + 16 * s + 8 * hi);
                dr = __builtin_amdgcn_mfma_f32_32x32x16_bf16(wr_, xf, dr, 0, 0, 0);
                di = __builtin_amdgcn_mfma_f32_32x32x16_bf16(wi_, xf, di, 0, 0, 0);
            }
            const int trow = 32 * tb + l31;
#pragma unroll
            for (int rr = 0; rr < 4; ++rr) { const int cc = 32 * chh + 8 * rr + 4 * hi;
                const f32x4 xc4 = *(const LAS f32x4*)(XC + trow * LR_P + cc);
                f32x4 a4, u4;
#pragma unroll
                for (int e = 0; e < 4; ++e) { const int r = 4 * rr + e;
                    const float rg = __builtin_amdgcn_rcpf(1.f + __expf(-(dr[r] + k_ba[r]))), ig = __builtin_amdgcn_rcpf(1.f + __expf(-(di[r] + k_bx[r])));
                    const float la = rg * k_sp[r];
                    a4[e] = __expf(la); u4[e] = __builtin_amdgcn_sqrtf(neg_expm1(2.f * la)) * (ig * xc4[e]); }
                *(LAS f32x4*)(AA + trow * LR_P + cc) = a4; *(LAS f32x4*)(UU + trow * LR_P + cc) = u4; }
        }
        __syncthreads();
        float av[16], uv[16];
        {   float hl = 0.f, ap = 1.f;
#pragma unroll
            for (int j = 0; j < 16; ++j) { av[j] = AA[(16 * seg + j) * LR_P + sc]; uv[j] = UU[(16 * seg + j) * LR_P + sc]; hl = av[j] * hl + uv[j]; ap *= av[j]; }
            SEGA[seg * 64 + sc] = ap; SEGH[seg * 64 + sc] = hl; }
        if (tile < 3) {
#pragma unroll
            for (int j = 0; j < 16; ++j) XC[(16 * seg + j) * LR_P + sc] = cb + cw[0] * bf2f(xr[j]) + cw[1] * bf2f(xr[j + 1]) + cw[2] * bf2f(xr[j + 2]) + cw[3] * bf2f(xr[j + 3]); }
        __syncthreads();
        {   float h = CARRY[(tile & 1) * 64 + sc], p = CARRYP[(tile & 1) * 64 + sc];
            for (int s = 0; s < seg; ++s) { const float sa_ = SEGA[s * 64 + sc]; h = sa_ * h + SEGH[s * 64 + sc]; p *= sa_; }
#pragma unroll
            for (int j = 0; j < 16; ++j) { h = av[j] * h + uv[j]; p *= av[j];
                f32x2_t hp_; hp_.x = h; hp_.y = p; hpp[(size_t)(t0 + 16 * seg + j) * 512] = hp_; }
            if (seg == 7) { CARRY[((tile + 1) & 1) * 64 + sc] = h; CARRYP[((tile + 1) & 1) * 64 + sc] = p; } }
    }
    asm volatile("s_waitcnt vmcnt(0)" ::: "memory");
    __syncthreads();
    if (wave == 0) {
        gu64* gran = (gu64*)(F.ws + WS_GRAN) + ((size_t)((layer * 32 + b * 8 + n) * 8) * 128);
        const float he = CARRY[lane], pe = CARRYP[lane];
        unsigned tag1; asm volatile("v_mov_b32 %0, 1" : "=v"(tag1));
        __hip_atomic_store(gran + (size_t)c * 128 + 2 * lane, ((unsigned long long)tag1 << 32) | (unsigned long long)__builtin_bit_cast(unsigned, he), RLX_AGENT);
        __hip_atomic_store(gran + (size_t)c * 128 + 2 * lane + 1, ((unsigned long long)tag1 << 32) | (unsigned long long)__builtin_bit_cast(unsigned, pe), RLX_AGENT);
        float hin = 0.f;
#pragma unroll 1
        for (int cb4 = 0; cb4 < c; cb4 += 4) {
            unsigned long long gh[4], gp[4]; unsigned spins = 0;
            for (;;) { bool ok = true;
#pragma unroll
                for (int q = 0; q < 4; ++q) if (cb4 + q < c) { gh[q] = __hip_atomic_load(gran + (size_t)(cb4 + q) * 128 + 2 * lane, RLX_AGENT); gp[q] = __hip_atomic_load(gran + (size_t)(cb4 + q) * 128 + 2 * lane + 1, RLX_AGENT); }
#pragma unroll
                for (int q = 0; q < 4; ++q) if (cb4 + q < c) ok = ok && ((gh[q] >> 32) == 1ull) && ((gp[q] >> 32) == 1ull);
                if (__all(ok)) break;
                __builtin_amdgcn_s_sleep(2); if (++spins > (1u << 22)) break; }
#pragma unroll
            for (int q = 0; q < 4; ++q) if (cb4 + q < c) hin = __builtin_bit_cast(float, (unsigned)gp[q]) * hin + __builtin_bit_cast(float, (unsigned)gh[q]);
        }
        HIN[lane] = hin;
    }
    __syncthreads();
    {   const float hin = HIN[sc];
        const bf16* bgp = Z + (rb + 512 * c + 64 * seg) * ZP + ZC_BG + ch0 + sc;
        const f32x2_t* hp2 = hpp + (size_t)(512 * c + 64 * seg) * 512;
        const int yrow = (int)rb + 512 * c + 64 * seg, ycol = 512 + ch0 + sc;
        f32x2_t hpv[2][16]; unsigned short gv[2][16];
#pragma unroll
        for (int j = 0; j < 16; ++j) { hpv[0][j] = hp2[(size_t)j * 512]; gv[0][j] = bgp[(size_t)j * ZP]; }
#pragma unroll
        for (int jb = 0; jb < 4; ++jb) {
            const int j0 = 16 * jb;
            if (jb < 3) {
#pragma unroll
                for (int j = 0; j < 16; ++j) { hpv[(jb + 1) & 1][j] = hp2[(size_t)(j0 + 16 + j) * 512]; gv[(jb + 1) & 1][j] = bgp[(size_t)(j0 + 16 + j) * ZP]; } }
#pragma unroll
            for (int j = 0; j < 16; ++j) *(bf16*)((char*)Y + pg8::img_a(yrow + j0 + j, ycol, 32)) = (bf16)(cvtpk(gelu_tanh(bf2f(gv[jb & 1][j])) * (hpv[jb & 1][j].x + hpv[jb & 1][j].y * hin), 0.f) & 0xffffu);
        }
    }
    __syncthreads();
}

#ifndef DBG_A2
#define DBG_A2 1
#endif
#ifndef DBG_C2
#define DBG_C2 1
#endif
#ifndef DBG_D2
#define DBG_D2 1
#endif
#ifndef DBG_DUP
#define DBG_DUP 0
#endif
constexpr int MXN_B = 256, MXN_GW = 27, MXN_WG = 10, MXN_AC = 16 * 48 + MXN_WG * MXN_GW, MXN_D = 512, MXN_EARLY = 128, MXN_N = 48, MX_ITEMS = MXN_EARLY + MXN_N + MXN_B + MXN_AC + MXN_D;
static_assert(MXN_WG * MXN_GW >= MXW_A + MXW_B, "weight items");
__device__ __forceinline__ void mixer_phase(Frame& F, int lq) {
    const int layer = lq & 3;
    LAS unsigned* itemw = (LAS unsigned*)(F.lds + LDSCTL_OFF);
    for (;;) {
        __syncthreads();
        if (F.tid == 0) *itemw = __hip_atomic_fetch_add((unsigned*)(F.ctl + CW_Q + 64 * lq), 1u, __ATOMIC_RELAXED, __HIP_MEMORY_SCOPE_AGENT);
        __syncthreads();
        const int it = __builtin_amdgcn_readfirstlane((int)*itemw);
        if (it >= MX_ITEMS) break;
        { int t_ = mk_tid(F.wv0); asm volatile("" : "+v"(t_)); F.tid = t_; F.lane = t_ & 63; F.wave = __builtin_amdgcn_readfirstlane(t_ >> 6); }
        int kind, ua, ub, uc;
        if (it < MXN_EARLY) { kind = 0; ua = (it & 7) >> 1; ub = 2 + (it & 1); uc = 31 - (it >> 3); }
        else if (it < MXN_EARLY + MXN_N) { const int r = it - MXN_EARLY; kind = 5; ua = r / 12; ub = r % 12; uc = 0; }
        else if (it < MXN_EARLY + MXN_N + MXN_B) { const int ib = it - MXN_EARLY - MXN_N; kind = 1; ua = (ib & 31) >> 3; ub = ib & 7; uc = ib >> 5; }
        else if (it < MXN_EARLY + MXN_N + MXN_B + MXN_AC) { const int r = it - MXN_EARLY - MXN_N - MXN_B, gw_ = (r < MXN_WG * (48 + MXN_GW)), r2 = gw_ ? r : r - MXN_WG * (48 + MXN_GW), g = gw_ ? r2 / (48 + MXN_GW) : MXN_WG + r2 / 48, w = gw_ ? r2 % (48 + MXN_GW) : r2 % 48;
            if (w < 32) { const int qb = 2 * (15 - g) + 1 - (w >> 4), ww = w & 15; kind = ((ww & 3) >= 2 && qb >= 16) ? 4 : 0; ua = ww >> 2; ub = ww & 3; uc = qb; }
            else if (w < 48) { kind = 2; ua = (w - 32) >> 2; ub = (w - 32) & 3; uc = 15 - g; }
            else { kind = 6; ua = MXN_GW * g + (w - 48); ub = 0; uc = 0; } }
        else { const int r = it - MXN_EARLY - MXN_N - MXN_B - MXN_AC; kind = 3; ua = (r & 7) >> 1; ub = r & 1; uc = 63 - (r >> 3); }
        if (kind == 0) {
#ifndef NO_A
#ifdef DBG_REPK
            for (int rr_ = 0; rr_ < ((DBG_REPK == 0 || (DBG_REPK == 6 && ub >= 2) || (DBG_REPK == 7 && ub < 2)) ? 2 : 1); ++rr_)
#endif
            unit_A(F, layer, ua, ub, uc);
#endif
        } else if (kind == 1) {
#ifndef NO_B
#ifdef DBG_REPK
            for (int rr_ = 0; rr_ < ((DBG_REPK == 1) ? 2 : 1); ++rr_)
#endif
            unit_B(F, layer, ua, ub, uc);
#endif
        } else if (kind == 2) {
#ifndef NO_C
#ifdef DBG_REPK
            for (int rr_ = 0; rr_ < ((DBG_REPK == 2) ? 2 : 1); ++rr_)
#endif
            unit_C(F, layer, ua, ub, uc);
#endif
        } else if (kind == 3) {
#ifndef NO_D
#ifdef DBG_REPK
            for (int rr_ = 0; rr_ < ((DBG_REPK == 3) ? 2 : 1); ++rr_)
#endif
            unit_D(F, layer, ua, ub, uc);
#endif
        } else if (kind == 5) {
            unit_N(F, layer, ua, ub);
        } else if (kind == 6) {
            unit_W(F, layer, ua);
        }
    }
}


#ifndef MK_SPLIT
#define MK_SPLIT 0
#endif
constexpr int NPHASES = 2 + 8 * DEPTH;
__global__ void __launch_bounds__(NTHREADS, 2) mk_fwd(Args args) {
    extern __shared__ __attribute__((aligned(16))) unsigned char lds[];
    Frame F;
    F.lds = (LAS unsigned char*)lds;
    F.tid = threadIdx.x; F.lane = F.tid & 63; F.wave = __builtin_amdgcn_readfirstlane(F.tid >> 6); F.wv0 = F.wave;
    F.G = gridDim.x; { const int bx = blockIdx.x; F.vcu = (F.G % 8 == 0) ? (bx % 8) * (F.G / 8) + bx / 8 : bx; }
    F.ws = args.ws; F.ctl = (gu32*)(args.ws + WS_CTL); F.out = args.out;
    F.a = &args;
    for (int u = F.tid; u < (LDS_BYTES - LDSCTL_OFF) / 4; u += NTHREADS) ((LAS unsigned*)(F.lds + LDSCTL_OFF))[u] = 0u;
    __syncthreads();
    volatile LAS unsigned* MISC = (volatile LAS unsigned*)(F.lds + MISC_OFF);
    XcdBarrier bar; bar.lead = false; bar.bar = (unsigned*)(F.ctl + CW_BAR); bar.x = 0; bar.st = nullptr;
    if (!MK_SPLIT) bar = xcd_barrier_post((unsigned*)(F.ctl + CW_BAR), MISC + 8);
    const int lo = args.ph_lo, hi = args.ph_hi;
#ifndef ONLY
#define ONLY -1
#endif
#define ON(j) (ONLY < 0 || ONLY == (j))
#ifndef REPEAT_MASK
#define REPEAT_MASK 0
#endif
#define REPS(j) (((REPEAT_MASK >> (j)) & 1) ? 2 : 1)
#define IN(k) (lo <= (k) && (k) < hi)
#ifndef DBG_SLEEP
#define DBG_SLEEP 0
#endif
#ifndef DBG_BAR2
#define DBG_BAR2 1
#endif
#define SEAM(k) do { if (IN(k) && IN((k) + 1)) { for (int br_ = 0; br_ < DBG_BAR2; ++br_) { XcdBarrier b_ = bar; asm volatile("" : "+s"(b_.bar), "+s"(b_.x)); b_.lead = (mk_tid(F.wv0) == 0); xcd_barrier(b_); } if (DBG_SLEEP) { for (int sl_ = 0; sl_ < DBG_SLEEP; ++sl_) __builtin_amdgcn_s_sleep(127); } } } while (0)

#define OPQ_WS() unsigned char* ws_ = F.ws; asm volatile("" : "+s"(ws_))
#define H ((bf16*)(ws_ + WS_H))
#define U ((bf16*)(ws_ + WS_U))
#define Zb ((bf16*)(ws_ + WS_Z))
#define Gb ((bf16*)(ws_ + WS_G))
#define Yb ((bf16*)(ws_ + WS_Y))
#define MIXb ((bf16*)(ws_ + WS_MIX))
#define HID ((bf16*)(ws_ + WS_G))

    for (int rep = 0; rep < REPS(8); ++rep) { if constexpr (ON(10)) if (IN(0)) { p0_weights(F); } SEAM(0); }
    if constexpr (ON(11)) if (IN(1)) { OPQ_WS(); norm_phase<1, false>(F, F.a->in[I_X], F.a->in[I_NORM_MIX], U, nullptr, 0); } SEAM(1);

#ifdef UNROLL_LAYERS
#pragma unroll
#endif
    for (int layer = 0; layer < DEPTH; ++layer) {
        const int pb = 2 + 8 * layer;
#define REFRESH() do { int t_ = mk_tid(F.wv0); asm volatile("" : "+v"(t_)); F.tid = t_; F.lane = t_ & 63; F.wave = __builtin_amdgcn_readfirstlane(t_ >> 6); } while (0)
        for (int rep = 0; rep < REPS(0); ++rep) {
        if constexpr (ON(0)) if (IN(pb + 0)) {
            OPQ_WS(); unsigned char* wl = ws_ + WS_W + (size_t)layer * W_LAYER;
#ifndef NO_ZG
            {   pg8::Gemm g{U, (const bf16*)(wl + WO_IN), M, ZP, DM}; pg8::StaticOrder S; S.init(M, ZP, F.G, (int)blockIdx.x);
                pg8::EpiZ E{Zb};
                pg8::gemm_phase<pg8::EpiZ, pg8::StaticOrder, true, true, false, true>(F.lds + RING_OFF, g, S, E, F.wv0); }
#endif
#ifndef NO_G8
            {   pg8::Gemm g{(const bf16*)(ws_ + WS_U8), (const bf16*)(ws_ + WS_W8 + (size_t)layer * (16 * MiB)), M, GP, DM / 2}; pg8::StaticOrder S; S.init(M, GP, F.G, (int)blockIdx.x);
                pg8::EpiG E{Gb, F.a->in[I_B_GATE] + (size_t)layer * GP, 1.f / (FP8_SA * FP8_SW)};
                pg8::gemm_phase<pg8::EpiG, pg8::StaticOrder, true, true, true, true>(F.lds + RING_OFF, g, S, E, F.wv0); }
#endif
        }
        SEAM(pb + 0); }
#ifndef NO_MIX
        for (int rep = 0; rep < REPS(1); ++rep) { if constexpr (ON(1)) if (IN(pb + 1)) { REFRESH(); mixer_phase(F, layer + 4 * rep); }
        SEAM(pb + 1); }
#endif
        for (int rep = 0; rep < REPS(2); ++rep) {
        if constexpr (ON(2)) if (IN(pb + 2)) {
            OPQ_WS(); unsigned char* wl = ws_ + WS_W + (size_t)layer * W_LAYER;
            pg8::Gemm g{Yb, (const bf16*)(wl + WO_BR), M, DM, DM}; pg8::StaticOrder S; S.init(M, DM, F.G, (int)blockIdx.x);
            pg8::EpiMix E{Gb, MIXb};
            pg8::gemm_phase<pg8::EpiMix, pg8::StaticOrder, true, true, false, true>(F.lds + RING_OFF, g, S, E, F.wv0);
        }
        SEAM(pb + 2); }
        if constexpr (ON(3)) if (IN(pb + 3)) {
            OPQ_WS(); unsigned char* wl = ws_ + WS_W + (size_t)layer * W_LAYER;
            pg8::Gemm g{MIXb, (const bf16*)(wl + WO_OUT), M, DM, DM}; pg8::StaticOrder S; S.init(M, DM, F.G, (int)blockIdx.x);
            pg8::EpiResid E{layer == 0 ? F.a->in[I_X] : nullptr, H};
            pg8::gemm_phase<pg8::EpiResid, pg8::StaticOrder, true, true, false, true>(F.lds + RING_OFF, g, S, E, F.wv0);
        }
        SEAM(pb + 3);
        for (int rep = 0; rep < REPS(4); ++rep) { if constexpr (ON(4)) if (IN(pb + 4)) { REFRESH(); OPQ_WS(); norm_phase<0, true>(F, H, F.a->in[I_NORM_FFN] + (size_t)layer * DM, U, nullptr, layer); }
        SEAM(pb + 4); }
        for (int rep = 0; rep < REPS(5); ++rep) {
        if constexpr (ON(5)) if (IN(pb + 5)) {
            OPQ_WS(); unsigned char* wl = ws_ + WS_W + (size_t)layer * W_LAYER;
            pg8::Gemm g{U, (const bf16*)(wl + WO_GU), M, NGU, DM}; pg8::StaticOrder S; S.init(M, NGU, F.G, (int)blockIdx.x);
            pg8::EpiSwiGLU E{HID};
            pg8::gemm_phase<pg8::EpiSwiGLU, pg8::StaticOrder, true, true, false, true>(F.lds + RING_OFF, g, S, E, F.wv0);
        }
        SEAM(pb + 5); }
        if constexpr (ON(6)) if (IN(pb + 6)) {
            OPQ_WS(); unsigned char* wl = ws_ + WS_W + (size_t)layer * W_LAYER;
            pg8::Gemm g{HID, (const bf16*)(wl + WO_DN), M, DM, DFF}; pg8::StaticOrder S; S.init(M, DM, F.G, (int)blockIdx.x);
            pg8::EpiResid E{nullptr, H};
            pg8::gemm_phase<pg8::EpiResid, pg8::StaticOrder, true, true, false, true>(F.lds + RING_OFF, g, S, E, F.wv0);
        }
        SEAM(pb + 6);
        if constexpr (ON(7)) if (IN(pb + 7)) { REFRESH(); OPQ_WS();
            if (layer + 1 < DEPTH) norm_phase<1, true>(F, H, F.a->in[I_NORM_MIX] + (size_t)(layer + 1) * DM, U, nullptr, layer + 1);
            else norm_phase<2, true>(F, H, F.a->in[I_NORM_FINAL], nullptr, F.out, 0);
        }
        if (layer + 1 < DEPTH) SEAM(pb + 7);
    }
#undef IN
#undef SEAM
#undef H
#undef U
#undef Zb
#undef Gb
#undef Yb
#undef MIXb
#undef HID
}

#ifndef DBG_STOP
#define DBG_STOP -1
#endif
#ifndef DBG_SRC
#define DBG_SRC 0
#endif
#ifndef DBG_COL
#define DBG_COL 0
#endif
__global__ void dbg_dump(const unsigned char* ws, float* out) {
    const size_t i = (size_t)blockIdx.x * blockDim.x + threadIdx.x; if (i >= (size_t)M * DM) return;
    const size_t r = i / DM, c = i % DM; float v;
    if (DBG_SRC == 0) v = bf2f(((const bf16*)(ws + WS_Y))[i]);
    else if (DBG_SRC == 1) v = bf2f(((const bf16*)(ws + WS_Z))[r * ZP + DBG_COL + c]);
    else if (DBG_SRC == 2) v = ((const float*)(ws + WS_H))[i];
    else if (DBG_SRC == 3) v = bf2f(((const bf16*)(ws + WS_MIX))[i]);
    else if (DBG_SRC == 4) v = bf2f(((const bf16*)(ws + WS_G))[r * GP + DBG_COL + c]);
    else v = bf2f(((const bf16*)(ws + WS_U))[i]);
    out[i] = v;
}
extern "C" void kernel_launch(void* const* d_in, const int* in_sizes, int n_in, void* d_out, int out_size, void* d_ws, size_t ws_size, hipStream_t stream) {
    static int grid = 0;
    if (grid == 0) {
        if (n_in != 25 || in_sizes[0] != M * DM || out_size != M * DM || ws_size < WS_END) { fprintf(stderr, "kernel_launch: unexpected shapes (n_in %d, in0 %d, out %d, ws %zu); nothing launched\n", n_in, n_in > 0 ? in_sizes[0] : -1, out_size, ws_size); grid = -1; return; }
        int dev = 0, cus = 0, per_cu = 0;
        if (hipGetDevice(&dev) != hipSuccess || hipDeviceGetAttribute(&cus, hipDeviceAttributeMultiprocessorCount, dev) != hipSuccess) { grid = -1; return; }
        if (hipFuncSetAttribute((const void*)mk_fwd, hipFuncAttributeMaxDynamicSharedMemorySize, LDS_BYTES) != hipSuccess) { fprintf(stderr, "kernel_launch: hipFuncSetAttribute failed\n"); grid = -1; return; }
        if (hipOccupancyMaxActiveBlocksPerMultiprocessor(&per_cu, (const void*)mk_fwd, NTHREADS, LDS_BYTES) != hipSuccess || per_cu < 1) { fprintf(stderr, "kernel_launch: occupancy query says %d workgroups per CU\n", per_cu); }
        (void)hipGetLastError();
        grid = cus;
    }
    if (grid < 0) return;
    if (hipMemsetAsync((char*)d_ws + WS_CTL, 0, CTL_ZERO_BYTES, stream) != hipSuccess) return;
    Args a{};
    for (int i = 0; i < 25; ++i) a.in[i] = (const float*)d_in[i];
    a.out = (float*)d_out; a.ws = (unsigned char*)d_ws;
#if MK_SPLIT
    for (int p = 0; p < NPHASES; ++p) { if (DBG_STOP >= 0 && p > DBG_STOP) break; a.ph_lo = p; a.ph_hi = p + 1; hipLaunchKernelGGL(mk_fwd, dim3(grid), dim3(NTHREADS), LDS_BYTES, stream, a); }
    if (DBG_STOP >= 0) hipLaunchKernelGGL(dbg_dump, dim3((M * DM + 255) / 256), dim3(256), 0, stream, (const unsigned char*)d_ws, (float*)d_out);
#else
    a.ph_lo = 0; a.ph_hi = NPHASES;
    hipLaunchKernelGGL(mk_fwd, dim3(grid), dim3(NTHREADS), LDS_BYTES, stream, a);
#endif
    const hipError_t le = hipPeekAtLastError();
    if (le != hipSuccess) fprintf(stderr, "kernel_launch: launch failed: %s\n", hipGetErrorName(le));
}
```
